# Optimizing an MI355X kernel written in HIP

```python
import jax, jax.numpy as jnp
from jax import lax
import numpy as np

D_MODEL = 4096
BATCH = 1
SEQ = 8192
DEPTH = 1
DEC_BATCH = 128
DEC_SEQ = 1
PAST_LEN = 8192
PAGE_SIZE = 128

D_RNN = D_MODEL
N_RG_BLOCKS = 16
RG_BLOCK = D_RNN // N_RG_BLOCKS
CONV_W = 4
RG_C = 8.0
HEAD_DIM = 128
N_Q_HEADS = D_MODEL // HEAD_DIM
N_KV_HEADS = 8
GQA_GROUP = N_Q_HEADS // N_KV_HEADS
WINDOW = 128
ATTN_BLOCK = WINDOW
Q_WIDTH = N_Q_HEADS * HEAD_DIM
KV_WIDTH = N_KV_HEADS * HEAD_DIM
D_FF = 11008
MACARON_WEIGHT = 0.5
NORM_EPS = 1e-6
IN_SPLITS = (D_RNN, 2 * D_RNN, 2 * D_RNN + Q_WIDTH, 2 * D_RNN + Q_WIDTH + KV_WIDTH,
             2 * D_RNN + Q_WIDTH + 2 * KV_WIDTH, 2 * D_RNN + Q_WIDTH + 2 * KV_WIDTH + D_MODEL)
IN_COLS = IN_SPLITS[-1] + D_MODEL

kernel_name = "griffin_swa_sink_macaron_step"


def _rms(x, g):
    xf = x.astype(jnp.float32)
    y = xf * lax.rsqrt(jnp.mean(xf * xf, axis=-1, keepdims=True) + NORM_EPS)
    return (y * g.astype(jnp.float32)).astype(x.dtype)


def _swiglu(x, wg, wu, wd):
    return (jax.nn.silu(x @ wg) * (x @ wu)) @ wd


def _block_diag(x, w, b):
    xb = x.reshape(x.shape[:-1] + (N_RG_BLOCKS, RG_BLOCK))
    y = jnp.einsum('btni,nij->btnj', xb, w) + b
    return y.reshape(x.shape)


def _causal_conv(x, prefix, w, b):
    xp = jnp.concatenate([prefix, x], axis=1)
    T = x.shape[1]
    y = b
    for j in range(CONV_W):
        y = y + w[j] * xp[:, j:j + T]
    return y, xp[:, -(CONV_W - 1):]


def _lin_combine(e1, e2):
    a1, b1 = e1
    a2, b2 = e2
    return a1 * a2, a2 * b1 + b2


def _rg_lru(x, pos, h0, w_a, b_a, w_x, b_x, lam):
    xf = x.astype(jnp.float32)
    r = jax.nn.sigmoid(_block_diag(x, w_a, b_a).astype(jnp.float32))
    i = jax.nn.sigmoid(_block_diag(x, w_x, b_x).astype(jnp.float32))
    log_a = RG_C * r * jax.nn.log_sigmoid(lam.astype(jnp.float32))
    a = jnp.exp(log_a)
    mult = jnp.where((pos == 0)[None, :, None], 1.0, jnp.sqrt(-jnp.expm1(2.0 * log_a)))
    u = mult * i * xf
    u = u.at[:, 0].add(a[:, 0] * h0.astype(jnp.float32))
    _, h = lax.associative_scan(_lin_combine, (a, u), axis=1)
    return h, h[:, -1]


def _alibi_slopes():
    return jnp.exp2(-8.0 * jnp.arange(1, N_Q_HEADS + 1, dtype=jnp.float32) / N_Q_HEADS)


def _attend_band(q, k, v, dist, valid, sinks):
    s = jnp.einsum('bnqkgd,bnskd->bnkgqs', q, k).astype(jnp.float32) * (HEAD_DIM ** -0.5)
    slopes = _alibi_slopes().reshape(N_KV_HEADS, GQA_GROUP, 1, 1)
    s = s - slopes * dist.astype(jnp.float32)
    s = jnp.where(valid[None, :, None, None], s, -jnp.inf)
    sink = sinks.astype(jnp.float32).reshape(N_KV_HEADS, GQA_GROUP, 1, 1)
    m = jnp.maximum(jnp.max(s, axis=-1, keepdims=True), sink)
    p = jnp.exp(s - m)
    p = p / (jnp.sum(p, axis=-1, keepdims=True) + jnp.exp(sink - m))
    return jnp.einsum('bnkgqs,bnskd->bnqkgd', p.astype(v.dtype), v)


def _prompt_attention(q, k, v, sinks):
    b, T = q.shape[:2]
    n = T // ATTN_BLOCK
    qb = q.reshape(b, n, ATTN_BLOCK, N_KV_HEADS, GQA_GROUP, HEAD_DIM)

    def band(z):
        zb = z.reshape(b, n, ATTN_BLOCK, N_KV_HEADS, HEAD_DIM)
        prev = jnp.concatenate([jnp.zeros_like(zb[:, :1]), zb[:, :-1]], axis=1)
        return jnp.concatenate([prev, zb], axis=2)

    qi = jnp.arange(ATTN_BLOCK)[:, None]
    kj = jnp.arange(2 * ATTN_BLOCK)[None, :]
    dist = qi + ATTN_BLOCK - kj
    band_ok = (dist >= 0) & (dist < WINDOW)
    has_prev = (jnp.arange(n) > 0)[:, None, None] | (kj >= ATTN_BLOCK)[None]
    valid = band_ok[None] & has_prev
    o = _attend_band(qb, band(k), band(v), dist, valid, sinks)
    return o.reshape(b, T, Q_WIDTH), k[:, -WINDOW:], v[:, -WINDOW:]


def _sample_attention(q, k, v, k_buf, v_buf, sinks):
    b, T = q.shape[:2]
    kk = jnp.concatenate([k_buf.astype(k.dtype), k], axis=1)
    vv = jnp.concatenate([v_buf.astype(v.dtype), v], axis=1)
    dist = jnp.arange(T)[:, None] + WINDOW - jnp.arange(WINDOW + T)[None, :]
    valid = ((dist >= 0) & (dist < WINDOW))[None]
    qb = q.reshape(b, 1, T, N_KV_HEADS, GQA_GROUP, HEAD_DIM)
    o = _attend_band(qb, kk[:, None], vv[:, None], dist, valid, sinks)
    return o.reshape(b, T, Q_WIDTH), kk[:, -WINDOW:], vv[:, -WINDOW:]


def _layer(x, pos, conv_buf, h0, k_buf, v_buf, p):
    b, T = x.shape[:2]
    x = x + MACARON_WEIGHT * _swiglu(_rms(x, p['norm_ffn1']), p['w_ffn1_gate'], p['w_ffn1_up'], p['w_ffn1_down'])
    xn = _rms(x, p['norm_mix'])
    xr, yr, q, k, v, g_rec, g_att = jnp.split(xn @ p['w_in'], IN_SPLITS, axis=-1)
    xc, conv_new = _causal_conv(xr, conv_buf.astype(x.dtype), p['conv_w'], p['conv_b'])
    h, h_last = _rg_lru(xc, pos, h0, p['rg_w_a'], p['rg_b_a'], p['rg_w_x'], p['rg_b_x'], p['rg_lambda'])
    y_rec = (h.astype(x.dtype) * jax.nn.gelu(yr)) @ p['w_lru_proj']
    q = _rms(q.reshape(b, T, N_Q_HEADS, HEAD_DIM), p['q_norm'])
    k = _rms(k.reshape(b, T, N_KV_HEADS, HEAD_DIM), p['k_norm'])
    v = v.reshape(b, T, N_KV_HEADS, HEAD_DIM)
    if k_buf is None:
        o, k_new, v_new = _prompt_attention(q, k, v, p['sinks'])
    else:
        o, k_new, v_new = _sample_attention(q, k, v, k_buf, v_buf, p['sinks'])
    y_att = o @ p['w_attn_proj']
    mixed = (jax.nn.sigmoid(g_rec) * y_rec + jax.nn.sigmoid(g_att) * y_att) @ p['w_out']
    x = x + mixed
    x = x + MACARON_WEIGHT * _swiglu(_rms(x, p['norm_ffn2']), p['w_ffn2_gate'], p['w_ffn2_up'], p['w_ffn2_down'])
    return x, conv_new, h_last.astype(x.dtype), k_new, v_new


def setup_inputs(seed: int = 0) -> dict:
    key = jax.random.key(seed)
    ks = iter(jax.random.split(key, 40))
    f32 = jnp.float32

    def nrm(shape, scale):
        return jax.random.normal(next(ks), shape, f32) * scale

    def gain(shape):
        return 1.0 + nrm(shape, 0.02)

    u = jnp.sqrt(jax.random.uniform(next(ks), (DEPTH, D_RNN), f32, 0.81, 0.998))
    rg_lambda = jnp.log(u) - jnp.log1p(-u)
    return {
        'x_prompt': nrm((BATCH, SEQ, D_MODEL), 1.0),
        'x_sample': nrm((DEC_BATCH, DEC_SEQ, D_MODEL), 1.0),
        'state_conv': nrm((DEPTH, DEC_BATCH, CONV_W - 1, D_RNN), 1.0),
        'state_h': nrm((DEPTH, DEC_BATCH, D_RNN), 0.5),
        'cache_k': nrm((DEPTH, DEC_BATCH, WINDOW, N_KV_HEADS, HEAD_DIM), 1.0),
        'cache_v': nrm((DEPTH, DEC_BATCH, WINDOW, N_KV_HEADS, HEAD_DIM), 1.0),
        'norm_ffn1': gain((DEPTH, D_MODEL)),
        'w_ffn1_gate': nrm((DEPTH, D_MODEL, D_FF), D_MODEL ** -0.5),
        'w_ffn1_up': nrm((DEPTH, D_MODEL, D_FF), D_MODEL ** -0.5),
        'w_ffn1_down': nrm((DEPTH, D_FF, D_MODEL), D_FF ** -0.5),
        'norm_mix': gain((DEPTH, D_MODEL)),
        'w_in': nrm((DEPTH, D_MODEL, IN_COLS), D_MODEL ** -0.5),
        'conv_w': nrm((DEPTH, CONV_W, D_RNN), CONV_W ** -0.5),
        'conv_b': nrm((DEPTH, D_RNN), 0.01),
        'rg_w_a': nrm((DEPTH, N_RG_BLOCKS, RG_BLOCK, RG_BLOCK), RG_BLOCK ** -0.5),
        'rg_b_a': nrm((DEPTH, N_RG_BLOCKS, RG_BLOCK), 0.01),
        'rg_w_x': nrm((DEPTH, N_RG_BLOCKS, RG_BLOCK, RG_BLOCK), RG_BLOCK ** -0.5),
        'rg_b_x': nrm((DEPTH, N_RG_BLOCKS, RG_BLOCK), 0.01),
        'rg_lambda': rg_lambda,
        'q_norm': gain((DEPTH, HEAD_DIM)),
        'k_norm': gain((DEPTH, HEAD_DIM)),
        'sinks': nrm((DEPTH, N_Q_HEADS), 0.5),
        'w_lru_proj': nrm((DEPTH, D_RNN, D_MODEL), D_RNN ** -0.5),
        'w_attn_proj': nrm((DEPTH, Q_WIDTH, D_MODEL), Q_WIDTH ** -0.5),
        'w_out': nrm((DEPTH, D_MODEL, D_MODEL), D_MODEL ** -0.5),
        'norm_ffn2': gain((DEPTH, D_MODEL)),
        'w_ffn2_gate': nrm((DEPTH, D_MODEL, D_FF), D_MODEL ** -0.5),
        'w_ffn2_up': nrm((DEPTH, D_MODEL, D_FF), D_MODEL ** -0.5),
        'w_ffn2_down': nrm((DEPTH, D_FF, D_MODEL), D_FF ** -0.5),
    }


def reference(x_prompt, x_sample, state_conv, state_h, cache_k, cache_v,
              norm_ffn1, w_ffn1_gate, w_ffn1_up, w_ffn1_down, norm_mix, w_in,
              conv_w, conv_b, rg_w_a, rg_b_a, rg_w_x, rg_b_x, rg_lambda,
              q_norm, k_norm, sinks, w_lru_proj, w_attn_proj, w_out,
              norm_ffn2, w_ffn2_gate, w_ffn2_up, w_ffn2_down):
    b_p, t_p = x_prompt.shape[:2]
    t_s = x_sample.shape[1]
    pos_p = jnp.arange(t_p)
    pos_s = PAST_LEN + jnp.arange(t_s)
    yp, ys = x_prompt, x_sample
    pc, ph, pk, pv, sc, sh, sk, sv = [], [], [], [], [], [], [], []
    for l in range(DEPTH):
        p = dict(norm_ffn1=norm_ffn1[l], w_ffn1_gate=w_ffn1_gate[l], w_ffn1_up=w_ffn1_up[l],
                 w_ffn1_down=w_ffn1_down[l], norm_mix=norm_mix[l], w_in=w_in[l],
                 conv_w=conv_w[l], conv_b=conv_b[l], rg_w_a=rg_w_a[l], rg_b_a=rg_b_a[l],
                 rg_w_x=rg_w_x[l], rg_b_x=rg_b_x[l], rg_lambda=rg_lambda[l],
                 q_norm=q_norm[l], k_norm=k_norm[l], sinks=sinks[l],
                 w_lru_proj=w_lru_proj[l], w_attn_proj=w_attn_proj[l], w_out=w_out[l],
                 norm_ffn2=norm_ffn2[l], w_ffn2_gate=w_ffn2_gate[l], w_ffn2_up=w_ffn2_up[l],
                 w_ffn2_down=w_ffn2_down[l])
        conv0 = jnp.zeros((b_p, CONV_W - 1, D_RNN), yp.dtype)
        h0 = jnp.zeros((b_p, D_RNN), jnp.float32)
        yp, c1, h1, k1, v1 = _layer(yp, pos_p, conv0, h0, None, None, p)
        ys, c2, h2, k2, v2 = _layer(ys, pos_s, state_conv[l], state_h[l], cache_k[l], cache_v[l], p)
        pc.append(c1); ph.append(h1); pk.append(k1); pv.append(v1)
        sc.append(c2); sh.append(h2); sk.append(k2); sv.append(v2)
    return (yp, ys, jnp.stack(pc), jnp.stack(ph), jnp.stack(pk), jnp.stack(pv),
            jnp.stack(sc), jnp.stack(sh), jnp.stack(sk), jnp.stack(sv))
```

```cpp
#include <hip/hip_runtime.h>
#include <cstdio>
#include <cstdint>

#ifndef MK_PER_PHASE
#define MK_PER_PHASE 0
#endif

#define GAS __attribute__((address_space(1)))
#define LAS __attribute__((address_space(3)))
typedef unsigned short bf16_t;
typedef short bf16x8 __attribute__((ext_vector_type(8)));
typedef float f32x2 __attribute__((ext_vector_type(2)));
typedef float f32x4 __attribute__((ext_vector_type(4)));
typedef float f32x16 __attribute__((ext_vector_type(16)));
typedef unsigned u32x4 __attribute__((ext_vector_type(4)));
typedef unsigned u32x2 __attribute__((ext_vector_type(2)));

constexpr int DM = 4096, FF = 11008, TP = 8192, NBD = 128, MV = TP + NBD, MP = 8448, NPAN = MP / 256;
constexpr int NQH = 32, NKV = 8, HD = 128, KVW = NKV * HD, INC = 22528;
constexpr float EPS = 1e-6f;
constexpr int NPHASE = 12;

__device__ __forceinline__ unsigned cvt_pk_bf16(float lo, float hi) { unsigned r; asm volatile("v_cvt_pk_bf16_f32 %0, %1, %2" : "=v"(r) : "v"(lo), "v"(hi)); return r; }
__device__ __forceinline__ float bf_lo(unsigned w) { return __uint_as_float(w << 16); }
__device__ __forceinline__ float bf_hi(unsigned w) { return __uint_as_float(w & 0xffff0000u); }
__device__ __forceinline__ float bf2f(bf16_t b) { return __uint_as_float(((unsigned)b) << 16); }
__device__ __forceinline__ float rsq(float x) { return __builtin_amdgcn_rsqf(x); }
__device__ __forceinline__ float rcp(float x) { return __builtin_amdgcn_rcpf(x); }
__device__ __forceinline__ float sigm(float x) { return rcp(1.f + __expf(-x)); }
__device__ __forceinline__ float sig1(float v, float c1, float c2, float k0, float k1) { const float sg = sigm(v * (c1 + c2 * (v * v))); return sg * (k0 + k1 * v); }
__device__ __forceinline__ float gelu_tanh(float x) { return x * sigm(1.5957691216057308f * (x + 0.044715f * x * x * x)); }
__device__ __forceinline__ void unpack8(const u32x4 w, float (&o)[8]) { o[0] = bf_lo(w.x); o[1] = bf_hi(w.x); o[2] = bf_lo(w.y); o[3] = bf_hi(w.y); o[4] = bf_lo(w.z); o[5] = bf_hi(w.z); o[6] = bf_lo(w.w); o[7] = bf_hi(w.w); }
__device__ __forceinline__ u32x4 pack8(const float (&o)[8]) { u32x4 w; w.x = cvt_pk_bf16(o[0], o[1]); w.y = cvt_pk_bf16(o[2], o[3]); w.z = cvt_pk_bf16(o[4], o[5]); w.w = cvt_pk_bf16(o[6], o[7]); return w; }

template <int CTRL> __device__ __forceinline__ float dpp_mov(float x) { return __int_as_float(__builtin_amdgcn_update_dpp(0, __float_as_int(x), CTRL, 0xF, 0xF, false)); }
__device__ __forceinline__ float xrow16_sum(float x) {
    auto s = __builtin_amdgcn_permlane16_swap(__float_as_uint(x), __float_as_uint(x), false, false); x = __uint_as_float(s[0]) + __uint_as_float(s[1]);
    auto t = __builtin_amdgcn_permlane32_swap(__float_as_uint(x), __float_as_uint(x), false, false); return __uint_as_float(t[0]) + __uint_as_float(t[1]);
}
__device__ __forceinline__ float xrow16_max(float x) {
    auto s = __builtin_amdgcn_permlane16_swap(__float_as_uint(x), __float_as_uint(x), false, false); x = fmaxf(__uint_as_float(s[0]), __uint_as_float(s[1]));
    auto t = __builtin_amdgcn_permlane32_swap(__float_as_uint(x), __float_as_uint(x), false, false); return fmaxf(__uint_as_float(t[0]), __uint_as_float(t[1]));
}
__device__ __forceinline__ float rowsum16(float x) { x += dpp_mov<0xB1>(x); x += dpp_mov<0x4E>(x); x += dpp_mov<0x141>(x); x += dpp_mov<0x140>(x); return x; }
namespace pg8 {
constexpr int BM = 256, BK = 64, HALF = 128, HTB = HALF * BK * 2, STAGE_BYTES = 8 * HTB, NXCD = 8, WGM = 8;
__host__ __device__ __forceinline__ int lds_byte(int r, int c) { const int st = (r >> 4) * 2 + (c >> 5), rr = r & 15, cc = c & 31, ob = rr * 64 + cc * 2; return st * 1024 + (ob ^ (((ob >> 9) & 1) << 5)); }
__host__ __device__ __forceinline__ void stage_rc(int b, int& R, int& C) { const int st = b / 1024, sb = b % 1024, swz = sb ^ (((sb >> 9) & 1) << 5); R = (st >> 1) * 16 + swz / 64; C = (st & 1) * 32 + (swz % 64) / 2; }
__host__ __device__ __forceinline__ int perm32(int rho) { const int n = rho >> 4, i = rho & 15; return 8 * (i >> 2) + 4 * n + (i & 3); }

struct Unit { int pm, pn, half; };
struct Gemm { const bf16_t* A; const bf16_t* Bt; int lda, ldb, K; size_t ksA, ksB, dA, dB; };

template <int MODE> struct Order {
    int nM, nN, nwg, G, c, nH, rem, nShort, myFull;
    __device__ void init(int nM_, int nN_, int nH_, int G_, int c_) { nM = nM_; nN = nN_; nwg = nM * nN; G = G_; c = c_; nH = nH_; const int tot = MODE == 5 ? 2 * nwg : nwg; rem = tot % G; myFull = tot / G + (c < rem ? 1 : 0); nShort = rem ? G - rem : G; }
    __device__ bool next(int i, Unit& u) const {
        if (i >= myFull) {
            if (nH == 0) return false;
            const int s = rem ? c - rem : c; if (s < 0) return false;
            const int h = s + (i - myFull) * nShort; if (h >= nH) return false;
            u.pm = nM; u.pn = h; u.half = 1; return true;
        }
        int wgid = i * G + c; int kind2 = 0; if (MODE == 5 && wgid >= nwg) { wgid -= nwg; kind2 = 2; }
        { const int q = nwg / NXCD, r = nwg % NXCD, xcd = wgid % NXCD, off = wgid / NXCD; wgid = (xcd < r ? xcd * (q + 1) : r * (q + 1) + (xcd - r) * q) + off; }
        const int nig = WGM * nN, gid = wgid / nig, fm = gid * WGM, gsz = (nM - fm) < WGM ? (nM - fm) : WGM;
        u.pm = fm + ((wgid % nig) % gsz); u.pn = (wgid % nig) / gsz; u.half = kind2;
        if (MODE == 2 && u.pn >= 52) u.pn += 4;
        return true;
    }
    __device__ __forceinline__ size_t a_off(const Unit& u, const Gemm& g) const { size_t o = (size_t)u.pm * 256 * g.lda * 2; if (MODE == 1) o += (size_t)(u.pn >> 1) * 512; if (MODE == 5 && u.half == 2) o += g.dA; return o; }
    __device__ __forceinline__ size_t b_off(const Unit& u, const Gemm& g) const { return (size_t)u.pn * 256 * g.ldb * 2 + ((MODE == 5 && u.half == 2) ? g.dB : 0); }
};

template <class Epi, class Sched>
__device__ __forceinline__ void gemm_phase(LAS unsigned char* lds, const Gemm g, const Sched& S, const Epi& E) {
    const int tid = threadIdx.x, wid = __builtin_amdgcn_readfirstlane(tid >> 6), lane = tid & 63, wr = wid >> 2, wc = wid & 3, fr = lane & 15, fq = lane >> 4;
    int K = g.K; asm volatile("" : "+s"(K));
    const int nt = K / BK;
    unsigned voffA[2], voffB[2];
#pragma unroll
    for (int i = 0; i < 2; ++i) { int R, C; stage_rc(tid * 16 + i * 8192, R, C); const int Rb = (R & ~31) + perm32(R & 31);
        voffA[i] = (unsigned)(R * g.lda + C) * 2u; voffB[i] = (unsigned)(Rb * g.ldb + C) * 2u; }
    const size_t kstepA = g.ksA, kstepB = g.ksB;
    const size_t hstepA = (size_t)HALF * g.lda * 2, hstepB = (size_t)HALF * g.ldb * 2;
    const unsigned ldsw = (unsigned)wid * 1024u;
    const int aoff = lds_byte(wr * 64 + fr, fq * 8), boff = lds_byte(wc * 32 + fr, fq * 8);
#define PG8_SA(b, h) (((b) * 2 + (h)) * HTB)
#define PG8_SB(b, h) ((4 + (b) * 2 + (h)) * HTB)
#define PG8_STAGE(bufoff, gbase, voff) do { _Pragma("unroll") for (int _i = 0; _i < 2; ++_i) \
        __builtin_amdgcn_global_load_lds((const unsigned*)((const char*)(gbase) + (voff)[_i]), (LAS unsigned*)(lds + (bufoff) + ldsw + _i * 8192), 16, 0, 0); } while (0)
#define PG8_LDA(dst, b, h) do { _Pragma("unroll") for (int m = 0; m < 4; ++m) _Pragma("unroll") for (int k = 0; k < 2; ++k) dst[m][k] = *(const LAS bf16x8*)(lds + PG8_SA(b, h) + aoff + m * 2048 + k * 1024); } while (0)
#define PG8_LDB(dst, b, h) do { _Pragma("unroll") for (int n = 0; n < 2; ++n) _Pragma("unroll") for (int k = 0; k < 2; ++k) dst[n][k] = *(const LAS bf16x8*)(lds + PG8_SB(b, h) + boff + n * 2048 + k * 1024); } while (0)
#define PG8_MMA(ai, bj, At, Bt) do { __builtin_amdgcn_s_setprio(1); _Pragma("unroll") for (int m = 0; m < 4; ++m) _Pragma("unroll") for (int n = 0; n < 2; ++n) _Pragma("unroll") for (int k = 0; k < 2; ++k) \
        acc[ai][bj][m][n] = __builtin_amdgcn_mfma_f32_16x16x32_bf16(Bt[n][k], At[m][k], acc[ai][bj][m][n], 0, 0, 0); __builtin_amdgcn_s_setprio(0); } while (0)
#define PG8_WAIT_V(n) asm volatile("s_waitcnt vmcnt(" #n ")" ::: "memory")
#define PG8_WAIT_L(n) asm volatile("s_waitcnt lgkmcnt(" #n ")" ::: "memory")
#define PG8_BAR __builtin_amdgcn_s_barrier()
#define PG8_SCHED __builtin_amdgcn_sched_barrier(0)
    Unit cur, nxt; int ui = 0;
    if (!S.next(0, cur)) return;
    f32x4 acc[2][2][4][2];
#pragma unroll
    for (int a = 0; a < 2; ++a)
#pragma unroll
        for (int b = 0; b < 2; ++b)
#pragma unroll
            for (int m = 0; m < 4; ++m)
#pragma unroll
                for (int n = 0; n < 2; ++n) acc[a][b][m][n] = (f32x4){0.f, 0.f, 0.f, 0.f};
    bf16x8 At[4][2], B0[2][2], B1[2][2];
    const char* cA = (const char*)g.A + S.a_off(cur, g); const char* cB = (const char*)g.Bt + S.b_off(cur, g);
    PG8_STAGE(PG8_SB(0, 0), cB, voffB); PG8_STAGE(PG8_SB(0, 1), cB + hstepB, voffB); PG8_STAGE(PG8_SA(0, 0), cA, voffA); PG8_STAGE(PG8_SA(0, 1), cA + hstepA, voffA);
    if (wr == 1) PG8_BAR;
    PG8_WAIT_V(2); PG8_BAR;
    PG8_STAGE(PG8_SB(1, 0), cB + kstepB, voffB); PG8_STAGE(PG8_SA(1, 0), cA + kstepA, voffA); PG8_STAGE(PG8_SB(1, 1), cB + hstepB + kstepB, voffB);
    PG8_WAIT_V(6); PG8_BAR;
    for (;;) {
        const bool has_next = S.next(ui + 1, nxt);
        float pre[8]; E.prefetch(pre, cur, wr, fr);
        const char* nA = has_next ? (const char*)g.A + S.a_off(nxt, g) : cA; const char* nB = has_next ? (const char*)g.Bt + S.b_off(nxt, g) : cB;
#define PG8_KLOOP(FULL) \
        for (int t = 0; t < nt; t += 2) { \
            const bool last = (t == nt - 2); \
            const char* a1 = cA + (size_t)(t + 1) * kstepA; \
            const char* a2 = last ? nA : cA + (size_t)(t + 2) * kstepA; const char* b2 = last ? nB : cB + (size_t)(t + 2) * kstepB; \
            const char* a3 = a2 + kstepA; const char* b3 = b2 + kstepB; \
              \
            PG8_LDB(B0, 0, 0); PG8_LDB(B1, 0, 1); PG8_SCHED; PG8_LDA(At, 0, 0); PG8_STAGE(PG8_SA(1, 1), a1 + hstepA, voffA); \
            PG8_WAIT_V(8); PG8_WAIT_L(0); PG8_BAR; PG8_MMA(0, 0, At, B0); PG8_MMA(0, 1, At, B1); PG8_BAR; PG8_SCHED; \
              \
            if (FULL) PG8_LDA(At, 0, 1); PG8_STAGE(PG8_SB(0, 0), b2, voffB); PG8_STAGE(PG8_SB(0, 1), b2 + hstepB, voffB); PG8_STAGE(PG8_SA(0, 0), a2, voffA); \
            PG8_WAIT_V(8); PG8_WAIT_L(0); PG8_BAR; if (FULL) { PG8_MMA(1, 0, At, B0); PG8_MMA(1, 1, At, B1); } PG8_BAR; PG8_SCHED; \
              \
            PG8_LDB(B0, 1, 0); PG8_LDB(B1, 1, 1); PG8_SCHED; PG8_LDA(At, 1, 0); PG8_STAGE(PG8_SA(0, 1), a2 + hstepA, voffA); \
            PG8_WAIT_V(8); PG8_WAIT_L(0); PG8_BAR; PG8_MMA(0, 0, At, B0); PG8_MMA(0, 1, At, B1); PG8_BAR; PG8_SCHED; \
              \
            if (FULL) PG8_LDA(At, 1, 1); PG8_STAGE(PG8_SB(1, 0), b3, voffB); PG8_STAGE(PG8_SB(1, 1), b3 + hstepB, voffB); PG8_STAGE(PG8_SA(1, 0), a3, voffA); \
            PG8_WAIT_V(8); PG8_WAIT_L(0); PG8_BAR; if (FULL) { PG8_MMA(1, 0, At, B0); PG8_MMA(1, 1, At, B1); } PG8_BAR; PG8_SCHED; \
        }
        if (cur.half != 1) { PG8_KLOOP(1) } else { PG8_KLOOP(0) }
#undef PG8_KLOOP
        if (wr == 0) PG8_BAR;
        E(acc, cur, wr, wc, fr, fq, lds + STAGE_BYTES, pre);
        if (!has_next) break;
#pragma unroll
        for (int a = 0; a < 2; ++a)
#pragma unroll
            for (int b = 0; b < 2; ++b)
#pragma unroll
                for (int m = 0; m < 4; ++m)
#pragma unroll
                    for (int n = 0; n < 2; ++n) acc[a][b][m][n] = (f32x4){0.f, 0.f, 0.f, 0.f};
        cur = nxt; cA = nA; cB = nB; ++ui;
        if (wr == 1) PG8_BAR;
    }
    PG8_WAIT_V(0);
    PG8_BAR;
#undef PG8_SA
#undef PG8_SB
#undef PG8_STAGE
#undef PG8_LDA
#undef PG8_LDB
#undef PG8_MMA
#undef PG8_WAIT_V
#undef PG8_WAIT_L
#undef PG8_BAR
#undef PG8_SCHED
}
}
using pg8::Unit;

#define EPI_ARGS const f32x4 (&acc)[2][2][4][2], const Unit& u, int wr, int wc, int fr, int fq, LAS unsigned char* xl, const float (&pre)[8]
#define EPI_NO_PREFETCH __device__ __forceinline__ void prefetch(float (&pre)[8], const Unit&, int, int) const { _Pragma("unroll") for (int i = 0; i < 8; ++i) pre[i] = 0.f; }
#define EPI_SS_PREFETCH __device__ __forceinline__ void prefetch(float (&pre)[8], const Unit& u, int wr, int fr) const { const int row0 = u.pm * 256 + wr * 64 + fr; \
    _Pragma("unroll") for (int ai = 0; ai < 2; ++ai) _Pragma("unroll") for (int m = 0; m < 4; ++m) pre[ai * 4 + m] = ss[row0 + ai * 128 + m * 16]; }

struct EpiSwiglu {
    bf16_t* H; const float* ss;
    EPI_SS_PREFETCH
    __device__ __forceinline__ void operator()(EPI_ARGS) const {
        const int row0 = u.pm * 256 + wr * 64 + fr, col0 = u.pn * 128 + wc * 32 + 8 * fq;
#pragma unroll
        for (int ai = 0; ai < 2; ++ai) if (!(ai == 1 && u.half == 1))
#pragma unroll
            for (int m = 0; m < 4; ++m) {
                const int row = row0 + ai * 128 + m * 16; const float rs = rsq(pre[ai * 4 + m] * (1.f / DM) + EPS);
                float o[8];
#pragma unroll
                for (int n = 0; n < 2; ++n)
#pragma unroll
                    for (int j = 0; j < 4; ++j) { const float gg = acc[ai][0][m][n][j] * rs, uu = acc[ai][1][m][n][j] * rs; o[4 * n + j] = gg * sigm(gg) * uu; }
                *(u32x4*)(H + ((size_t)(col0 >> 6) * MP + row) * 64 + (col0 & 63)) = pack8(o);
            }
    }
};
template <int MODE> struct EpiResid {
    EPI_NO_PREFETCH
    const float* Xin; bf16_t* XB; float* out; float* ssn; float sc;
    __device__ __forceinline__ void operator()(EPI_ARGS) const {
        const int row0 = u.pm * 256 + wr * 64 + fr, col0 = u.pn * 256 + wc * 32 + 8 * fq;
#pragma unroll
        for (int ai = 0; ai < 2; ++ai) if (!(ai == 1 && u.half == 1)) {
            f32x4 xf[4][2][2]; u32x4 xb[4][2];
#pragma unroll
            for (int m = 0; m < 4; ++m)
#pragma unroll
                for (int bj = 0; bj < 2; ++bj) { const size_t off = (size_t)(row0 + ai * 128 + m * 16) * DM + col0 + bj * 128;
                    if (MODE == 0) { xf[m][bj][0] = *(const f32x4*)(Xin + off); xf[m][bj][1] = *(const f32x4*)(Xin + off + 4); } else xb[m][bj] = *(const u32x4*)(XB + off); }
            asm volatile("" ::: "memory");
#pragma unroll
            for (int m = 0; m < 4; ++m) {
                const int row = row0 + ai * 128 + m * 16; float q = 0.f;
#pragma unroll
                for (int bj = 0; bj < 2; ++bj) {
                    const size_t off = (size_t)row * DM + col0 + bj * 128;
                    f32x4 x0, x1;
                    if (MODE == 0) { x0 = xf[m][bj][0]; x1 = xf[m][bj][1]; }
                    else { float t[8]; unpack8(xb[m][bj], t); x0 = (f32x4){t[0], t[1], t[2], t[3]}; x1 = (f32x4){t[4], t[5], t[6], t[7]}; }
                    const f32x4 v0 = x0 + acc[ai][bj][m][0] * sc, v1 = x1 + acc[ai][bj][m][1] * sc;
                    if (MODE == 2) { if (row < MV) { *(f32x4*)(out + off) = v0; *(f32x4*)(out + off + 4) = v1; } }
                    else {
                        u32x4 w; w.x = cvt_pk_bf16(v0[0], v0[1]); w.y = cvt_pk_bf16(v0[2], v0[3]); w.z = cvt_pk_bf16(v1[0], v1[1]); w.w = cvt_pk_bf16(v1[2], v1[3]);
                        *(u32x4*)(XB + off) = w;
                        q += (v0[0] * v0[0] + v0[1] * v0[1]) + (v0[2] * v0[2] + v0[3] * v0[3]) + (v1[0] * v1[0] + v1[1] * v1[1]) + (v1[2] * v1[2] + v1[3] * v1[3]);
                    }
                }
                if (MODE != 2) { q = xrow16_sum(q); if (fq == 0) __hip_atomic_fetch_add(ssn + row, q, __ATOMIC_RELAXED, __HIP_MEMORY_SCOPE_AGENT); }
            }
        }
    }
};
struct EpiWin {
    EPI_SS_PREFETCH
    bf16_t *XR, *YG, *Q, *KB, *VD, *GR, *GA; const float* ss; const float *qg, *kg;
    __device__ __forceinline__ void operator()(EPI_ARGS) const {
        const int pn = u.pn; int mode, ld, cb; bf16_t* dst;
        if (pn < 16) { mode = 0; dst = XR; ld = DM; cb = pn * 256; }
        else if (pn < 32) { mode = 1; dst = YG; ld = DM; cb = (pn - 16) * 256; }
        else if (pn < 48) { mode = 2; dst = Q; ld = DM; cb = (pn - 32) * 256; }
        else if (pn < 52) { mode = 2; dst = KB; ld = KVW; cb = (pn - 48) * 256; }
        else if (pn < 56) { mode = 0; dst = VD - (size_t)TP * KVW; ld = KVW; cb = (pn - 52) * 256; }
        else if (pn < 72) { mode = 3; dst = GR; ld = DM; cb = (pn - 56) * 256; }
        else { mode = 3; dst = GA; ld = DM; cb = (pn - 72) * 256; }
        const int rl0 = wr * 64 + fr, row0 = u.pm * 256 + rl0, col0 = cb + wc * 32 + 8 * fq;
        float rsv[2][4];
#pragma unroll
        for (int ai = 0; ai < 2; ++ai) if (!(ai == 1 && u.half == 1))
#pragma unroll
            for (int m = 0; m < 4; ++m) rsv[ai][m] = rsq(pre[ai * 4 + m] * (1.f / DM) + EPS);
        if (mode == 2) {
            LAS float* XL = (LAS float*)xl;
            const float* gp = (pn < 48 ? qg : kg) + wc * 32 + 8 * fq;
            float gv[8];
#pragma unroll
            for (int j = 0; j < 8; ++j) gv[j] = gp[j];
#pragma unroll
            for (int ai = 0; ai < 2; ++ai) if (!(ai == 1 && u.half == 1))
#pragma unroll
                for (int m = 0; m < 4; ++m)
#pragma unroll
                    for (int bj = 0; bj < 2; ++bj) {
                        const f32x4 a0 = acc[ai][bj][m][0], a1 = acc[ai][bj][m][1];
                        float q = (a0[0] * a0[0] + a0[1] * a0[1]) + (a0[2] * a0[2] + a0[3] * a0[3]) + (a1[0] * a1[0] + a1[1] * a1[1]) + (a1[2] * a1[2] + a1[3] * a1[3]);
                        q = xrow16_sum(q);
                        if (fq == 0) XL[((rl0 + ai * 128 + m * 16) * 2 + bj) * 4 + wc] = q * rsv[ai][m] * rsv[ai][m];
                    }
            asm volatile("s_waitcnt lgkmcnt(0)" ::: "memory"); __builtin_amdgcn_s_barrier(); asm volatile("" ::: "memory");
#pragma unroll
            for (int ai = 0; ai < 2; ++ai) if (!(ai == 1 && u.half == 1))
#pragma unroll
                for (int m = 0; m < 4; ++m)
#pragma unroll
                    for (int bj = 0; bj < 2; ++bj) {
                        const f32x4 p = *(const LAS f32x4*)(XL + ((rl0 + ai * 128 + m * 16) * 2 + bj) * 4);
                        const float hr = rsq(((p[0] + p[1]) + (p[2] + p[3])) * (1.f / HD) + EPS) * rsv[ai][m];
                        float o[8];
#pragma unroll
                        for (int n = 0; n < 2; ++n)
#pragma unroll
                            for (int j = 0; j < 4; ++j) o[4 * n + j] = acc[ai][bj][m][n][j] * hr * gv[4 * n + j];
                        *(u32x4*)(dst + (size_t)(row0 + ai * 128 + m * 16) * ld + col0 + bj * 128) = pack8(o);
                    }
            asm volatile("s_waitcnt lgkmcnt(0)" ::: "memory"); __builtin_amdgcn_s_barrier(); asm volatile("" ::: "memory");
        } else {
#define EPIWIN_LOOP(EXPR) _Pragma("unroll") for (int ai = 0; ai < 2; ++ai) if (!(ai == 1 && u.half == 1)) _Pragma("unroll") for (int m = 0; m < 4; ++m) _Pragma("unroll") for (int bj = 0; bj < 2; ++bj) { \
                float o[8]; _Pragma("unroll") for (int n = 0; n < 2; ++n) _Pragma("unroll") for (int j = 0; j < 4; ++j) { const float v = acc[ai][bj][m][n][j] * rsv[ai][m]; o[4 * n + j] = (EXPR); } \
                *(u32x4*)(dst + (size_t)(row0 + ai * 128 + m * 16) * ld + col0 + bj * 128) = pack8(o); }
            if (mode == 0) { EPIWIN_LOOP(v) }
            else { const bool ge = (mode == 1);
                   const float c1 = ge ? 1.5957691216057308f : 1.f, c2 = ge ? 1.5957691216057308f * 0.044715f : 0.f, k0 = ge ? 0.f : 1.f, k1 = ge ? 1.f : 0.f;
                   EPIWIN_LOOP(sig1(v, c1, c2, k0, k1)) }
#undef EPIWIN_LOOP
        }
    }
};
struct EpiVT {
    EPI_NO_PREFETCH
    bf16_t* VT; const float* ss;
    __device__ __forceinline__ void operator()(EPI_ARGS) const {
        const int row0 = u.pm * 256 + wr * 64 + fr, col0 = u.pn * 256 + wc * 32 + 8 * fq;
        float rc[2][8];
#pragma unroll
        for (int bj = 0; bj < 2; ++bj)
#pragma unroll
            for (int j = 0; j < 8; ++j) rc[bj][j] = rsq(ss[col0 + bj * 128 + j] * (1.f / DM) + EPS);
#pragma unroll
        for (int ai = 0; ai < 2; ++ai) if (!(ai == 1 && u.half == 1))
#pragma unroll
            for (int m = 0; m < 4; ++m)
#pragma unroll
                for (int bj = 0; bj < 2; ++bj) {
                    float o[8];
#pragma unroll
                    for (int n = 0; n < 2; ++n)
#pragma unroll
                        for (int j = 0; j < 4; ++j) o[4 * n + j] = acc[ai][bj][m][n][j] * rc[bj][4 * n + j];
                    *(u32x4*)(VT + (size_t)(row0 + ai * 128 + m * 16) * MP + col0 + bj * 128) = pack8(o);
                }
    }
};
struct EpiGates {
    EPI_NO_PREFETCH
    unsigned* AU; const bf16_t* XC; const float *ba, *bx, *Lc;
    __device__ __forceinline__ void operator()(EPI_ARGS) const {
        const int row0 = u.pm * 256 + wr * 64 + fr, ch0 = (u.pn >> 1) * 256 + (u.pn & 1) * 128 + wc * 32 + 8 * fq;
        float va[8], vx[8], vl[8];
#pragma unroll
        for (int j = 0; j < 8; ++j) { va[j] = ba[ch0 + j]; vx[j] = bx[ch0 + j]; vl[j] = Lc[ch0 + j]; }
        u32x4 xcin[2][4];
#pragma unroll
        for (int ai = 0; ai < 2; ++ai) if (!(ai == 1 && u.half == 1))
#pragma unroll
            for (int m = 0; m < 4; ++m) xcin[ai][m] = *(const u32x4*)(XC + (size_t)(row0 + ai * 128 + m * 16) * DM + ch0);
        asm volatile("" ::: "memory");
#pragma unroll
        for (int ai = 0; ai < 2; ++ai) if (!(ai == 1 && u.half == 1))
#pragma unroll
            for (int m = 0; m < 4; ++m) {
                const int row = row0 + ai * 128 + m * 16; const size_t off = (size_t)row * DM + ch0;
                float xc[8]; unpack8(xcin[ai][m], xc);
                float a[8], uu[8];
#pragma unroll
                for (int n = 0; n < 2; ++n)
#pragma unroll
                    for (int j = 0; j < 4; ++j) { const int e = 4 * n + j;
                        const float r = sigm(acc[ai][0][m][n][j] + va[e]), ig = sigm(acc[ai][1][m][n][j] + vx[e]);
                        const float l2 = r * vl[e], av = __builtin_amdgcn_exp2f(l2); const float mult = (row == 0) ? 1.f : __builtin_amdgcn_sqrtf(fmaxf(1.f - av * av, 0.f));
                        a[e] = l2; uu[e] = mult * ig * xc[e]; }
                u32x4 w0, w1; w0.x = cvt_pk_bf16(a[0], uu[0]); w0.y = cvt_pk_bf16(a[1], uu[1]); w0.z = cvt_pk_bf16(a[2], uu[2]); w0.w = cvt_pk_bf16(a[3], uu[3]);
                w1.x = cvt_pk_bf16(a[4], uu[4]); w1.y = cvt_pk_bf16(a[5], uu[5]); w1.z = cvt_pk_bf16(a[6], uu[6]); w1.w = cvt_pk_bf16(a[7], uu[7]);
                *(u32x4*)(AU + off) = w0; *(u32x4*)(AU + off + 4) = w1;
            }
    }
};
struct EpiProj {
    EPI_NO_PREFETCH
    const bf16_t* GR; const bf16_t* GA; bf16_t* MIX; int force2;
    __device__ __forceinline__ void operator()(EPI_ARGS) const {
        const bool second = (u.half == 2) || force2; const bf16_t* G = second ? GA : GR;
        const int row0 = u.pm * 256 + wr * 64 + fr, col0 = u.pn * 256 + wc * 32 + 8 * fq;
#pragma unroll
        for (int ai = 0; ai < 2; ++ai) if (!(ai == 1 && u.half == 1)) {
            u32x4 gin[4][2], tin[4][2];
#pragma unroll
            for (int m = 0; m < 4; ++m)
#pragma unroll
                for (int bj = 0; bj < 2; ++bj) { const size_t off = (size_t)(row0 + ai * 128 + m * 16) * DM + col0 + bj * 128; gin[m][bj] = *(const u32x4*)(G + off); tin[m][bj] = second ? *(const u32x4*)(MIX + off) : (u32x4){0u, 0u, 0u, 0u}; }
            asm volatile("" ::: "memory");
#pragma unroll
            for (int m = 0; m < 4; ++m)
#pragma unroll
                for (int bj = 0; bj < 2; ++bj) {
                    const size_t off = (size_t)(row0 + ai * 128 + m * 16) * DM + col0 + bj * 128;
                    float gt[8], t[8]; unpack8(gin[m][bj], gt); unpack8(tin[m][bj], t);
                    float o[8];
#pragma unroll
                    for (int n = 0; n < 2; ++n)
#pragma unroll
                        for (int j = 0; j < 4; ++j) o[4 * n + j] = gt[4 * n + j] * acc[ai][bj][m][n][j] + t[4 * n + j];
                    *(u32x4*)(MIX + off) = pack8(o);
                }
        }
    }
};

constexpr size_t al256(size_t x) { return (x + 255) & ~(size_t)255; }
constexpr size_t SZ_WGU = (size_t)2 * FF * DM * 2, SZ_WD = (size_t)DM * FF * 2, SZ_WIN = (size_t)INC * DM * 2, SZ_WG = (size_t)32 * 256 * 256 * 2, SZ_WP = (size_t)DM * DM * 2;
constexpr size_t SZ_A16 = (size_t)MP * DM * 2, SZ_A32 = (size_t)MP * DM * 4, SZ_H = (size_t)MP * FF * 2, SZ_KV = (size_t)MP * KVW * 2;
constexpr size_t WS_CTL = 0, CTL_ZERO_BYTES = 1u << 20;
constexpr int NCH = 64, CHR = TP / NCH;
constexpr size_t WS_AGG = 1u << 20;
constexpr size_t WS_LC = WS_AGG + (size_t)2 * NCH * DM * 4;
constexpr size_t WS_WGU1 = al256(WS_LC + DM * 4);
constexpr size_t WS_WD1 = WS_WGU1 + SZ_WGU, WS_WIN = WS_WD1 + SZ_WD, WS_WG = WS_WIN + SZ_WIN, WS_WL = WS_WG + SZ_WG, WS_WA = WS_WL + SZ_WP, WS_WO = WS_WA + SZ_WP;
constexpr size_t WS_WGU2 = WS_WO + SZ_WP, WS_WD2 = WS_WGU2 + SZ_WGU;
constexpr size_t WS_XB = WS_WD2 + SZ_WD;
constexpr size_t WS_R = WS_XB + SZ_A16;
constexpr size_t WS_XR = WS_R, WS_YG = WS_XR + SZ_A16, WS_Q = WS_YG + SZ_A16, WS_GR = WS_Q + SZ_A16, WS_GA = WS_GR + SZ_A16, WS_KB = WS_GA + SZ_A16, WS_VT = WS_KB + SZ_KV;
constexpr size_t WS_H = WS_R;
constexpr size_t WS_XC = WS_VT + SZ_KV;
constexpr size_t WS_VD = WS_XC + SZ_A16;
constexpr size_t WS_END = WS_VD + (size_t)NBD * KVW * 2;
constexpr size_t WS_AO = WS_WGU1;
static_assert(WS_AO + SZ_A32 <= WS_WG, "a/u overlay must stay inside the dead weight region");
static_assert(SZ_H <= WS_XC - WS_R, "H overlay");
constexpr int CW_BAR = 4096;
constexpr size_t CTL_SS = 65536;
static_assert(CTL_SS + 3 * MP * 4 <= CTL_ZERO_BYTES, "ctl");
constexpr size_t O_Y = 0, O_PCONV = (size_t)MV * DM, O_PH = O_PCONV + 3 * DM, O_PK = O_PH + DM, O_PV = O_PK + 128 * KVW, O_SCONV = O_PV + 128 * KVW, O_SH = O_SCONV + (size_t)NBD * 3 * DM,
                 O_SK = O_SH + (size_t)NBD * DM, O_SV = O_SK + (size_t)NBD * 128 * KVW, O_END = O_SV + (size_t)NBD * 128 * KVW;

constexpr int XL_OFF = 131072, MISC_OFF = XL_OFF + 8192, LDS_BYTES = 147456;
constexpr int AT_KS = 272, AT_VS = 520, AT_VO = 256 * AT_KS;
static_assert(AT_VO + 128 * AT_VS <= MISC_OFF, "attention LDS image");

#define XB_TMO      128
#define XB_XCNT(j)  (256  + 64 * (j))
#define XB_XSUB(j)  (1280 + 64 * (j))
#define XB_XGEN(j)  (2304 + 64 * (j))
#define XB_TOP      3328
#define XB_TOPGEN   3392
#define XCD_BAR_WORDS 3456
#define XB_SPIN_CAP (1u << 22)
__device__ __forceinline__ unsigned xb_ld(unsigned* p)              { return __hip_atomic_load(p, __ATOMIC_RELAXED, __HIP_MEMORY_SCOPE_AGENT); }
__device__ __forceinline__ unsigned xb_add(unsigned* p, unsigned v) { return __hip_atomic_fetch_add(p, v, __ATOMIC_RELAXED, __HIP_MEMORY_SCOPE_AGENT); }
__device__ __forceinline__ unsigned xb_xcc_id() { return (unsigned)__builtin_amdgcn_s_getreg((3 << 11) | 20) & 0xFu; }
#define XB_SPIN(cond, bar) do { unsigned _sp = 0; while (cond) { __builtin_amdgcn_s_sleep(1); \
    if ((++_sp & 255u) == 0u) { if (xb_ld(&(bar)[XB_TMO])) break; if (_sp > XB_SPIN_CAP) { atomicAdd(&(bar)[XB_TMO], 1u); break; } } } } while (0)
struct XcdBarrier { unsigned* bar; unsigned x; volatile LAS unsigned* st; };
__device__ __forceinline__ XcdBarrier xcd_barrier_post(unsigned* bar, volatile LAS unsigned* st) {
    XcdBarrier b; b.bar = bar; b.x = xb_xcc_id(); b.st = st;
    if (threadIdx.x == 0) (void)xb_add(&bar[XB_XCNT(b.x)], 1u);
    return b;
}
__device__ __forceinline__ void xcd_barrier_complete(unsigned* bar, unsigned x, unsigned& nloc, unsigned& nx) {
    const unsigned G = gridDim.x * gridDim.y * gridDim.z;
    unsigned sum, cnt, mine, sp = 0u;
    for (;;) {
        sum = 0u; cnt = 0u; mine = 0u;
#pragma unroll
        for (unsigned j = 0; j < 16; ++j) { const unsigned c = xb_ld(&bar[XB_XCNT(j)]); sum += c; cnt += (c > 0u) ? 1u : 0u; mine = (j == x) ? c : mine; }
        if (sum == G) break;
        __builtin_amdgcn_s_sleep(1);
        if ((++sp & 255u) == 0u) { if (xb_ld(&bar[XB_TMO])) break; if (sp > XB_SPIN_CAP) { atomicAdd(&bar[XB_TMO], 1u); break; } }
    }
    nloc = mine > 0u ? mine : 1u; nx = cnt > 0u ? cnt : 1u;
}
__device__ __forceinline__ void xcd_barrier(const XcdBarrier& b) {
    asm volatile("s_waitcnt vmcnt(0)" ::: "memory");
    __syncthreads();
    if (threadIdx.x == 0) {
        unsigned* bar = b.bar;
        __builtin_amdgcn_s_waitcnt(0);
        unsigned nloc = b.st[0], nx = b.st[1];
        if (nloc == 0u) { xcd_barrier_complete(bar, b.x, nloc, nx); b.st[0] = nloc; b.st[1] = nx; }
        const unsigned old = xb_add(&bar[XB_XSUB(b.x)], 1u);
        const unsigned gen = old / nloc;
        if (old + 1u == (gen + 1u) * nloc) {
            __builtin_amdgcn_fence(__ATOMIC_RELEASE, "agent");
            asm volatile("s_waitcnt vmcnt(0)" ::: "memory");
            const unsigned og = xb_add(&bar[XB_TOP], 1u);
            const unsigned tg = og / nx;
            if (og + 1u == (tg + 1u) * nx) xb_add(&bar[XB_TOPGEN], 1u);
            else XB_SPIN(xb_ld(&bar[XB_TOPGEN]) == tg, bar);
            __builtin_amdgcn_fence(__ATOMIC_ACQUIRE, "agent");
            xb_add(&bar[XB_XGEN(b.x)], 1u);
            asm volatile("s_waitcnt vmcnt(0)" ::: "memory");
        } else {
            XB_SPIN(xb_ld(&bar[XB_XGEN(b.x)]) == gen, bar);
            __builtin_amdgcn_fence(__ATOMIC_ACQUIRE, "agent");
            asm volatile("s_waitcnt vmcnt(0)" ::: "memory");
        }
    }
    __syncthreads();
}

struct Args { const float* in[29]; float* out; unsigned char* ws; int ph_lo, ph_hi; };
static_assert(sizeof(Args) == 29 * 8 + 8 + 8 + 8, "Args has no padding");
enum { I_XP = 0, I_XS, I_SCONV, I_SH, I_CK, I_CV, I_NF1, I_WG1, I_WU1, I_WD1, I_NMIX, I_WIN, I_CW, I_CB, I_RWA, I_RBA, I_RWX, I_RBX, I_LAM, I_QN, I_KN, I_SINK, I_WL, I_WA, I_WO, I_NF2, I_WG2, I_WU2, I_WD2 };

__device__ __forceinline__ float wave_sum(float v) {
#pragma unroll
    for (int o = 1; o < 64; o <<= 1) v += __shfl_xor(v, o);
    return v;
}
#define LDS_WAIT() asm volatile("s_waitcnt lgkmcnt(0)" ::: "memory")

struct TrItem { const float* src; bf16_t* dst; const float* gain; int N, ldk; };
__device__ __forceinline__ void tr_load(const TrItem& t, float (&v)[32], int lane) {
    const float* p = t.src + (size_t)(lane >> 5) * t.N + (lane & 31);
#pragma unroll
    for (int i = 0; i < 32; ++i) v[i] = p[(size_t)(2 * i) * t.N];
}
__device__ __forceinline__ void tr_store(const TrItem& t, const float (&v)[32], LAS float* scr, int lane) {
#pragma unroll
    for (int i = 0; i < 32; ++i) scr[(2 * i + (lane >> 5)) * 33 + (lane & 31)] = v[i];
    const int c = lane & 7;
    float gv[8];
#pragma unroll
    for (int i = 0; i < 8; ++i) gv[i] = t.gain ? t.gain[8 * c + i] : 1.f;
    LDS_WAIT(); asm volatile("" ::: "memory");
#pragma unroll
    for (int j = 0; j < 4; ++j) { const int n = (lane >> 3) + 8 * j; const LAS float* s = scr + (8 * c) * 33 + n;
        u32x4 o; o.x = cvt_pk_bf16(s[0 * 33] * gv[0], s[1 * 33] * gv[1]); o.y = cvt_pk_bf16(s[2 * 33] * gv[2], s[3 * 33] * gv[3]);
        o.z = cvt_pk_bf16(s[4 * 33] * gv[4], s[5 * 33] * gv[5]); o.w = cvt_pk_bf16(s[6 * 33] * gv[6], s[7 * 33] * gv[7]);
        *(u32x4*)(t.dst + (size_t)n * t.ldk + 8 * c) = o; }
}

constexpr int I_FF = (DM / 64) * (FF / 32);
constexpr int I_IN = (DM / 64) * (INC / 32), I_PJ = (DM / 64) * (DM / 32), I_RG = 16 * 4 * 8;
constexpr int NITEMS = 6 * I_FF + I_IN + 3 * I_PJ + 2 * I_RG;
#define TR_DECODE(t, it_) do { int r = (it_); \
    if (r < 4 * I_FF) { const int which = r / I_FF; r -= which * I_FF; const int kb = r / (FF / 32), nb = r % (FF / 32), n0 = 32 * nb, k0 = 64 * kb; \
        t.src = args.in[which == 0 ? I_WG1 : which == 1 ? I_WU1 : which == 2 ? I_WG2 : I_WU2] + (size_t)k0 * FF + n0; t.N = FF; \
        t.dst = (bf16_t*)(ws + (which < 2 ? WS_WGU1 : WS_WGU2)) + (size_t)(256 * (n0 >> 7) + (n0 & 127) + 128 * (which & 1)) * DM + k0; t.ldk = DM; t.gain = args.in[which < 2 ? I_NF1 : I_NF2] + k0; break; } \
    r -= 4 * I_FF; \
    if (r < 2 * I_FF) { const int which = r / I_FF; r -= which * I_FF; const int kb = r / (DM / 32), nb = r % (DM / 32), n0 = 32 * nb, k0 = 64 * kb; \
        t.src = args.in[which ? I_WD2 : I_WD1] + (size_t)k0 * DM + n0; t.N = DM; t.dst = (bf16_t*)(ws + (which ? WS_WD2 : WS_WD1)) + ((size_t)(k0 >> 6) * DM + n0) * 64; t.ldk = 64; t.gain = nullptr; break; }     \
    r -= 2 * I_FF; \
    if (r < I_IN) { const int kb = r / (INC / 32), nb = r % (INC / 32), n0 = 32 * nb, k0 = 64 * kb; \
        t.src = args.in[I_WIN] + (size_t)k0 * INC + n0; t.N = INC; t.dst = (bf16_t*)(ws + WS_WIN) + (size_t)n0 * DM + k0; t.ldk = DM; t.gain = args.in[I_NMIX] + k0; break; } \
    r -= I_IN; \
    if (r < 3 * I_PJ) { const int which = r / I_PJ; r -= which * I_PJ; const int kb = r / (DM / 32), nb = r % (DM / 32), n0 = 32 * nb, k0 = 64 * kb; \
        t.src = args.in[which == 0 ? I_WL : which == 1 ? I_WA : I_WO] + (size_t)k0 * DM + n0; t.N = DM; t.dst = (bf16_t*)(ws + (which == 0 ? WS_WL : which == 1 ? WS_WA : WS_WO)) + (size_t)n0 * DM + k0; t.ldk = DM; t.gain = nullptr; break; } \
    r -= 3 * I_PJ; \
    { const int which = r / I_RG; r -= which * I_RG; const int blk = r / 32, kb = (r % 32) / 8, nb = r % 8, n0 = 32 * nb, k0 = 64 * kb; \
        t.src = args.in[which ? I_RWX : I_RWA] + (size_t)blk * 65536 + (size_t)k0 * 256 + n0; t.N = 256; \
        t.dst = (bf16_t*)(ws + WS_WG) + (size_t)((blk * 2 + (n0 >> 7)) * 256 + (n0 & 127) + 128 * which) * 256 + k0; t.ldk = 256; t.gain = nullptr; } \
    } while (0)

constexpr int R_WGU1 = 0, R_WGU2 = 2 * I_FF, R_WD1 = 4 * I_FF, R_WD2 = 5 * I_FF, R_WIN = 6 * I_FF, R_PJ = R_WIN + I_IN, R_RG = R_PJ + 3 * I_PJ, R_END = R_RG + 2 * I_RG;
static_assert(R_END == NITEMS, "item ranges");
constexpr int CVG1 = 237, CVG3 = 242;
constexpr int CV3_WGU2 = 20480;
constexpr int CV0_WIN = 10240;
__device__ __forceinline__ void convert_items(const Args& args, unsigned char* ws, LAS unsigned char* lds, int lo, int hi, int rank, int nranks, int wave, int lane) {
    LAS float* scr0 = (LAS float*)(lds + wave * 16896); LAS float* scr1 = scr0 + 64 * 33;
    float v0[32], v1[32], v2[32], v3[32]; TrItem t0, t1, t2, t3;
    int it = lo + rank;
#define CV_LOAD(t, v, idx) do { const int i_ = (idx); if (i_ < hi) { TR_DECODE(t, i_); tr_load(t, v, lane); } } while (0)
    CV_LOAD(t0, v0, it); CV_LOAD(t1, v1, it + nranks); CV_LOAD(t2, v2, it + 2 * nranks); CV_LOAD(t3, v3, it + 3 * nranks);
    while (it < hi) {
        tr_store(t0, v0, scr0, lane); CV_LOAD(t0, v0, it + 4 * nranks);
        if (it + nranks >= hi) break;
        tr_store(t1, v1, scr1, lane); CV_LOAD(t1, v1, it + 5 * nranks);
        if (it + 2 * nranks >= hi) break;
        tr_store(t2, v2, scr0, lane); CV_LOAD(t2, v2, it + 6 * nranks);
        if (it + 3 * nranks >= hi) break;
        tr_store(t3, v3, scr1, lane); CV_LOAD(t3, v3, it + 7 * nranks);
        it += 4 * nranks;
    }
#undef CV_LOAD
    LDS_WAIT();
}

__device__ __forceinline__ void skinny_acc(const bf16_t* X, int lda, const bf16_t* Wt, int ldb, int kbeg, int ksteps, f32x4 (&acc)[4][2], int lane) {
    const int j = lane & 15, q = lane >> 4;
    const bf16_t* wp = Wt + (size_t)j * ldb + kbeg + 8 * q;
    const bf16_t* xp = X + (size_t)j * lda + kbeg + 8 * q;
    asm volatile("" : "+s"(ksteps));
#pragma unroll 4
    for (int s = 0; s < ksteps; ++s) {
        bf16x8 wf[2], xf[4];
#pragma unroll
        for (int nt = 0; nt < 2; ++nt) wf[nt] = *(const bf16x8*)(wp + (size_t)(16 * nt) * ldb + 32 * s);
#pragma unroll
        for (int mt = 0; mt < 4; ++mt) xf[mt] = *(const bf16x8*)(xp + (size_t)(16 * mt) * lda + 32 * s);
#pragma unroll
        for (int mt = 0; mt < 4; ++mt)
#pragma unroll
            for (int nt = 0; nt < 2; ++nt) acc[mt][nt] = __builtin_amdgcn_mfma_f32_16x16x32_bf16(wf[nt], xf[mt], acc[mt][nt], 0, 0, 0);
    }
}
__device__ __forceinline__ void skinny_acc_tm(const bf16_t* X, size_t tsX, const bf16_t* Wt, size_t tsW, int kbeg, int ksteps, f32x4 (&acc)[4][2], int lane) {
    const int j = lane & 15, q = lane >> 4;
    const bf16_t* wp = Wt + (size_t)j * 64 + 8 * q;
    const bf16_t* xp = X + (size_t)j * 64 + 8 * q;
    int g0 = kbeg >> 5;
    asm volatile("" : "+s"(ksteps));
#pragma unroll 4
    for (int s = 0; s < ksteps; ++s) {
        const int gi = g0 + s; const size_t tw = (size_t)(gi >> 1) * tsW + (gi & 1) * 32, tx = (size_t)(gi >> 1) * tsX + (gi & 1) * 32;
        bf16x8 wf[2], xf[4];
#pragma unroll
        for (int nt = 0; nt < 2; ++nt) wf[nt] = *(const bf16x8*)(wp + tw + (size_t)(16 * nt) * 64);
#pragma unroll
        for (int mt = 0; mt < 4; ++mt) xf[mt] = *(const bf16x8*)(xp + tx + (size_t)(16 * mt) * 64);
#pragma unroll
        for (int mt = 0; mt < 4; ++mt)
#pragma unroll
            for (int nt = 0; nt < 2; ++nt) acc[mt][nt] = __builtin_amdgcn_mfma_f32_16x16x32_bf16(wf[nt], xf[mt], acc[mt][nt], 0, 0, 0);
    }
}
__device__ __forceinline__ void skinny_zero(f32x4 (&acc)[4][2]) {
#pragma unroll
    for (int mt = 0; mt < 4; ++mt)
#pragma unroll
        for (int nt = 0; nt < 2; ++nt) acc[mt][nt] = (f32x4){0.f, 0.f, 0.f, 0.f};
}
__device__ __forceinline__ void skinny_store(LAS float* part, const f32x4 (&acc)[4][2], int wave, int lane) {
    const int j = lane & 15, q = lane >> 4;
#pragma unroll
    for (int mt = 0; mt < 4; ++mt)
#pragma unroll
        for (int nt = 0; nt < 2; ++nt) *(LAS f32x4*)(part + ((wave * 64 + 16 * mt + j) * 32 + 16 * nt + 4 * q)) = acc[mt][nt];
}
__device__ __forceinline__ f32x4 skinny_sum(const LAS float* part, int rowl, int c4) {
    f32x4 sum = (f32x4){0.f, 0.f, 0.f, 0.f};
#pragma unroll
    for (int w = 0; w < 8; ++w) sum += *(const LAS f32x4*)(part + ((w * 64 + rowl) * 32 + 4 * c4));
    return sum;
}
template <int MODE, bool TM> __device__ __forceinline__ void skinny_resid(LAS unsigned char* lds, const bf16_t* Xa, int lda, const bf16_t* Wt, int K, const float* Xin, bf16_t* XB, float* ssn, float* out, float sc, int G, int bx, int tid, int wave, int lane) {
    LAS float* part = (LAS float*)lds;
    for (int unit = bx; unit < 2 * (DM / 32); unit += G) {
        const int r0 = 64 * (unit & 1), n0 = 32 * (unit >> 1);
        f32x4 acc[4][2]; skinny_zero(acc);
        if (TM) skinny_acc_tm(Xa + (size_t)r0 * 64, (size_t)MP * 64, Wt + (size_t)n0 * 64, (size_t)DM * 64, wave * (K / 8), K / 256, acc, lane);
        else skinny_acc(Xa + (size_t)r0 * lda, lda, Wt + (size_t)n0 * K, K, wave * (K / 8), K / 256, acc, lane);
        skinny_store(part, acc, wave, lane);
        __syncthreads();
        const int rowl = tid >> 3, c4 = tid & 7; const size_t off = (size_t)(TP + r0 + rowl) * DM + n0 + 4 * c4;
        f32x4 xin;
        if (MODE == 0) xin = *(const f32x4*)(Xin + off); else { const u32x2 xb = *(const u32x2*)(XB + off); xin = (f32x4){bf_lo(xb.x), bf_hi(xb.x), bf_lo(xb.y), bf_hi(xb.y)}; }
        const f32x4 v = xin + skinny_sum(part, rowl, c4) * sc;
        if (MODE == 2) *(f32x4*)(out + off) = v;
        else {
            u32x2 w; w.x = cvt_pk_bf16(v[0], v[1]); w.y = cvt_pk_bf16(v[2], v[3]); *(u32x2*)(XB + off) = w;
            float q = (v[0] * v[0] + v[1] * v[1]) + (v[2] * v[2] + v[3] * v[3]); q += __shfl_xor(q, 1); q += __shfl_xor(q, 2); q += __shfl_xor(q, 4);
            if (c4 == 0) __hip_atomic_fetch_add(ssn + TP + r0 + rowl, q, __ATOMIC_RELAXED, __HIP_MEMORY_SCOPE_AGENT);
        }
        __syncthreads();
    }
}

__global__ void __launch_bounds__(512, 2) mk_fwd(Args args) {
    extern __shared__ __attribute__((aligned(16))) unsigned char lds_raw[];
    LAS unsigned char* lds = (LAS unsigned char*)lds_raw;
    volatile LAS unsigned* MISC = (volatile LAS unsigned*)(lds + MISC_OFF);
    const int tid = threadIdx.x, lane = tid & 63, wave = __builtin_amdgcn_readfirstlane(tid >> 6);
    const int G = gridDim.x, bx = blockIdx.x;
    const int vcu = (G % 8 == 0) ? (bx % 8) * (G / 8) + bx / 8 : bx;
    unsigned char* ws = args.ws;
    unsigned* ctl = (unsigned*)(ws + WS_CTL);
    float* SS0 = (float*)(ws + WS_CTL + CTL_SS); float* SS1 = SS0 + MP; float* SS2 = SS1 + MP;
    float* CP = (float*)(ws + WS_AGG); float* CH = CP + NCH * DM; float* LC = (float*)(ws + WS_LC);
    bf16_t* WGU1 = (bf16_t*)(ws + WS_WGU1); bf16_t* WD1 = (bf16_t*)(ws + WS_WD1); bf16_t* WIN = (bf16_t*)(ws + WS_WIN); bf16_t* WGT = (bf16_t*)(ws + WS_WG);
    bf16_t* WL = (bf16_t*)(ws + WS_WL); bf16_t* WA = (bf16_t*)(ws + WS_WA); bf16_t* WO = (bf16_t*)(ws + WS_WO); bf16_t* WGU2 = (bf16_t*)(ws + WS_WGU2); bf16_t* WD2 = (bf16_t*)(ws + WS_WD2);
    bf16_t* XB = (bf16_t*)(ws + WS_XB);
    bf16_t* XR = (bf16_t*)(ws + WS_XR); bf16_t* YG = (bf16_t*)(ws + WS_YG); bf16_t* QB = (bf16_t*)(ws + WS_Q); bf16_t* GR = (bf16_t*)(ws + WS_GR); bf16_t* GA = (bf16_t*)(ws + WS_GA);
    bf16_t* KB = (bf16_t*)(ws + WS_KB); bf16_t* VT = (bf16_t*)(ws + WS_VT); bf16_t* HB = (bf16_t*)(ws + WS_H); bf16_t* XC = (bf16_t*)(ws + WS_XC); bf16_t* MIX = XC; bf16_t* VD = (bf16_t*)(ws + WS_VD);
    unsigned* AU = (unsigned*)(ws + WS_AO);
    float* out = args.out;

    for (int i = tid; i < (LDS_BYTES - MISC_OFF) / 4; i += 512) ((LAS unsigned*)(lds + MISC_OFF))[i] = 0u;
    __syncthreads();
    XcdBarrier bar; bar.bar = ctl + CW_BAR; bar.x = 0; bar.st = nullptr;
    if (!MK_PER_PHASE) bar = xcd_barrier_post(ctl + CW_BAR, MISC + 8);
    const int lo = args.ph_lo, hi = args.ph_hi;
    const bool cvsplit = (G == 256);
#define IN(k) (lo <= (k) && (k) < hi)
#define SEAM(k) do { if (IN(k) && IN((k) + 1)) xcd_barrier(bar); } while (0)

    if (IN(0)) {
        const int gw = vcu * 8 + wave, NGW = G * 8;
        if (!cvsplit) convert_items(args, ws, lds, 0, NITEMS, gw, NGW, wave, lane);
        else {
            convert_items(args, ws, lds, R_WGU1, R_WGU2, gw, NGW, wave, lane);
            convert_items(args, ws, lds, R_WGU2 + CV3_WGU2, R_WD1, gw, NGW, wave, lane);
            convert_items(args, ws, lds, R_WIN, R_WIN + CV0_WIN, gw, NGW, wave, lane);
        }
        for (int m = gw; m < MP; m += NGW) {
            const float* src = m < TP ? args.in[I_XP] + (size_t)m * DM : (m < MV ? args.in[I_XS] + (size_t)(m - TP) * DM : nullptr);
            float s = 0.f;
#pragma unroll
            for (int j = 0; j < 16; ++j) {
                const int c = 4 * lane + 256 * j; f32x4 v = src ? *(const f32x4*)(src + c) : (f32x4){0.f, 0.f, 0.f, 0.f};
                u32x2 w; w.x = cvt_pk_bf16(v[0], v[1]); w.y = cvt_pk_bf16(v[2], v[3]); *(u32x2*)(XB + (size_t)m * DM + c) = w;
                s += (v[0] * v[0] + v[1] * v[1]) + (v[2] * v[2] + v[3] * v[3]); }
            s = wave_sum(s); if (lane == 0) SS0[m] = s;
        }
        for (int c = bx * 512 + tid; c < DM; c += G * 512) { const float l = args.in[I_LAM][c]; LC[c] = 8.f * 1.4426950408889634f * (fminf(l, 0.f) - log1pf(__expf(-fabsf(l)))); }
    }
    SEAM(0);

    if (IN(1)) {
        if (cvsplit && bx >= CVG1) {
            const int rk = (bx - CVG1) * 8 + wave, nr = (G - CVG1) * 8;
            convert_items(args, ws, lds, R_WD1, R_WD2, rk, nr, wave, lane);
            convert_items(args, ws, lds, R_WIN + CV0_WIN, R_PJ, rk, nr, wave, lane);
        } else {
        pg8::Gemm g{XB, WGU1, DM, DM, DM, 128, 128, 0, 0}; pg8::Order<0> S; S.init(32, 2 * FF / 256, 2 * FF / 256, cvsplit ? CVG1 : G, bx);
        EpiSwiglu E{HB, SS0};
        pg8::gemm_phase(lds, g, S, E);
        }
    }
    SEAM(1);
    if (IN(2)) {
        pg8::Gemm g{HB, WD1, 64, 64, FF, (size_t)MP * 128, (size_t)DM * 128, 0, 0};   pg8::Order<0> S; S.init(32, DM / 256, 0, G, bx);
        EpiResid<1> E{nullptr, XB, nullptr, SS1, 0.5f};
        pg8::gemm_phase(lds, g, S, E);
        skinny_resid<1, true>(lds, HB + (size_t)TP * 64, 64, WD1, FF, nullptr, XB, SS1, nullptr, 0.5f, G, bx, tid, wave, lane);
    }
    SEAM(2);
    if (IN(3)) {
        if (cvsplit && bx >= CVG3) {
            const int rk = (bx - CVG3) * 8 + wave, nr = (G - CVG3) * 8;
            convert_items(args, ws, lds, R_PJ, R_END, rk, nr, wave, lane);
            convert_items(args, ws, lds, R_WGU2, R_WGU2 + CV3_WGU2, rk, nr, wave, lane);
        } else {
        const int GG = cvsplit ? CVG3 : G;
        { pg8::Gemm g{XB, WIN, DM, DM, DM, 128, 128, 0, 0}; pg8::Order<2> S; S.init(32, INC / 256 - 4, INC / 256, GG, bx);
          EpiWin E{XR, YG, QB, KB, VD, GR, GA, SS1, args.in[I_QN], args.in[I_KN]};
          pg8::gemm_phase(lds, g, S, E); }
        const int remM = (32 * (INC / 256 - 4)) % GG, sV = bx - remM - INC / 256;
        const int nV = cvsplit ? 128 : G, cV = cvsplit ? sV : (bx + G / 2) % G;
        if (cV >= 0 && cV < nV) { pg8::Gemm g{WIN + (size_t)(2 * DM + DM + KVW) * DM, XB, DM, DM, DM, 128, 128, 0, 0}; pg8::Order<0> S; S.init(KVW / 256, 32, 0, nV, cV);
          EpiVT E{VT, SS1};
          pg8::gemm_phase(lds, g, S, E); }
        }
    }
    SEAM(3);
    if (IN(4)) {
        const float* cw = args.in[I_CW]; const float* cbias = args.in[I_CB];
        const bool spec = (G == 256); const int cth = spec ? tid - 256 : tid, cnt = spec ? 256 : 512;
        if (!spec || wave >= 4) {
        for (int s = bx * cnt + cth; s < 256 * 512; s += G * cnt) {
            const int rc = s >> 9, c0 = (s & 511) * 8, r0 = rc * 32;
            float w0[8], w1[8], w2[8], w3[8], cb[8];
#pragma unroll
            for (int j = 0; j < 8; ++j) { w0[j] = cw[c0 + j]; w1[j] = cw[DM + c0 + j]; w2[j] = cw[2 * DM + c0 + j]; w3[j] = cw[3 * DM + c0 + j]; cb[j] = cbias[c0 + j]; }
            float xm3[8], xm2[8], xm1[8];
            if (r0 == 0) {
#pragma unroll
                for (int j = 0; j < 8; ++j) { xm3[j] = 0.f; xm2[j] = 0.f; xm1[j] = 0.f; }
            } else { unpack8(*(const u32x4*)(XR + (size_t)(r0 - 3) * DM + c0), xm3); unpack8(*(const u32x4*)(XR + (size_t)(r0 - 2) * DM + c0), xm2); unpack8(*(const u32x4*)(XR + (size_t)(r0 - 1) * DM + c0), xm1); }
            for (int rb = r0; rb < r0 + 32; rb += 16) {
                u32x4 xin[16];
#pragma unroll
                for (int q = 0; q < 16; ++q) xin[q] = *(const u32x4*)(XR + (size_t)(rb + q) * DM + c0);
#pragma unroll
                for (int q = 0; q < 16; ++q) {
                    float x[8], o[8]; unpack8(xin[q], x);
#pragma unroll
                    for (int j = 0; j < 8; ++j) { o[j] = cb[j] + w0[j] * xm3[j] + w1[j] * xm2[j] + w2[j] * xm1[j] + w3[j] * x[j]; xm3[j] = xm2[j]; xm2[j] = xm1[j]; xm1[j] = x[j]; }
                    *(u32x4*)(XC + (size_t)(rb + q) * DM + c0) = pack8(o);
                }
            }
            if (r0 == TP - 32) {
#pragma unroll
                for (int j = 0; j < 8; ++j) { out[O_PCONV + c0 + j] = xm3[j]; out[O_PCONV + DM + c0 + j] = xm2[j]; out[O_PCONV + 2 * DM + c0 + j] = xm1[j]; }
            }
        }
        for (int s = bx * cnt + cth; s < NBD * 512; s += G * cnt) {
            const int b = s >> 9, c0 = (s & 511) * 8, rr = TP + b;
            const float* p = args.in[I_SCONV] + (size_t)b * 3 * DM + c0; float* so = out + O_SCONV + (size_t)b * 3 * DM + c0;
            const f32x4 p0a = *(const f32x4*)p, p0b = *(const f32x4*)(p + 4), p1a = *(const f32x4*)(p + DM), p1b = *(const f32x4*)(p + DM + 4), p2a = *(const f32x4*)(p + 2 * DM), p2b = *(const f32x4*)(p + 2 * DM + 4);
            float x[8], o[8]; unpack8(*(const u32x4*)(XR + (size_t)rr * DM + c0), x);
            const f32x4 w0a = *(const f32x4*)(cw + c0), w0b = *(const f32x4*)(cw + c0 + 4), w1a = *(const f32x4*)(cw + DM + c0), w1b = *(const f32x4*)(cw + DM + c0 + 4);
            const f32x4 w2a = *(const f32x4*)(cw + 2 * DM + c0), w2b = *(const f32x4*)(cw + 2 * DM + c0 + 4), w3a = *(const f32x4*)(cw + 3 * DM + c0), w3b = *(const f32x4*)(cw + 3 * DM + c0 + 4);
            const f32x4 cba = *(const f32x4*)(cbias + c0), cbb = *(const f32x4*)(cbias + c0 + 4);
#pragma unroll
            for (int j = 0; j < 4; ++j) { o[j] = cba[j] + w0a[j] * p0a[j] + w1a[j] * p1a[j] + w2a[j] * p2a[j] + w3a[j] * x[j]; o[4 + j] = cbb[j] + w0b[j] * p0b[j] + w1b[j] * p1b[j] + w2b[j] * p2b[j] + w3b[j] * x[4 + j]; }
            *(f32x4*)so = p1a; *(f32x4*)(so + 4) = p1b; *(f32x4*)(so + DM) = p2a; *(f32x4*)(so + DM + 4) = p2b;
            *(f32x4*)(so + 2 * DM) = (f32x4){x[0], x[1], x[2], x[3]}; *(f32x4*)(so + 2 * DM + 4) = (f32x4){x[4], x[5], x[6], x[7]};
            *(u32x4*)(XC + (size_t)rr * DM + c0) = pack8(o);
        }
        for (int e = bx * cnt + cth; e < 128 * KVW; e += G * cnt) {
            const int tok = e >> 10, gd = e & 1023;
            out[O_PK + e] = bf2f(KB[(size_t)(TP - 128 + tok) * KVW + gd]);
            out[O_PV + e] = bf2f(VT[(size_t)gd * MP + TP - 128 + tok]);
        }
        }
        {
            const float* ck = args.in[I_CK]; const float* cv = args.in[I_CV];
            const float scale = 0.08838834764831845f;
            const int r = lane >> 4, i8 = (lane & 15) * 8;
            for (int p = wave * G + vcu; p < NBD * NKV; p += G * 8) {
                const int b = p >> 3, g = p & 7; const size_t row = (size_t)(TP + b);
                float q[4][8], o[4][8], m[4], l[4], slope[4];
#pragma unroll
                for (int hh = 0; hh < 4; ++hh) { unpack8(*(const u32x4*)(QB + row * DM + (4 * g + hh) * 128 + i8), q[hh]);
                    const float sink = args.in[I_SINK][4 * g + hh]; m[hh] = (r == 0) ? sink : -1e30f; l[hh] = (r == 0) ? 1.f : 0.f; slope[hh] = exp2f(-8.f * (float)(4 * g + hh + 1) / 32.f);
#pragma unroll
                    for (int e = 0; e < 8; ++e) o[hh][e] = 0.f; }
                const float* kp = ck + (((size_t)b * 128) * NKV + g) * HD + i8; const float* vp = cv + (((size_t)b * 128) * NKV + g) * HD + i8;
                float* ko = out + O_SK + (((size_t)b * 128) * NKV + g) * HD + i8; float* vo = out + O_SV + (((size_t)b * 128) * NKV + g) * HD + i8;
                f32x4 ka, kb, va, vb;
                { const int kk = r + 1; ka = *(const f32x4*)(kp + (size_t)kk * KVW); kb = *(const f32x4*)(kp + (size_t)kk * KVW + 4); va = *(const f32x4*)(vp + (size_t)kk * KVW); vb = *(const f32x4*)(vp + (size_t)kk * KVW + 4); }
                for (int it = 0; it < 32; ++it) {
                    const int kk = 4 * it + r + 1;
                    float kf[8] = {ka[0], ka[1], ka[2], ka[3], kb[0], kb[1], kb[2], kb[3]}, vf[8] = {va[0], va[1], va[2], va[3], vb[0], vb[1], vb[2], vb[3]};
                    if (it < 31) { const int kn = kk + 4;
                        if (kn < 128) { ka = *(const f32x4*)(kp + (size_t)kn * KVW); kb = *(const f32x4*)(kp + (size_t)kn * KVW + 4); va = *(const f32x4*)(vp + (size_t)kn * KVW); vb = *(const f32x4*)(vp + (size_t)kn * KVW + 4); }
                        else { float t[8]; unpack8(*(const u32x4*)(KB + row * KVW + g * 128 + i8), t); ka = (f32x4){t[0], t[1], t[2], t[3]}; kb = (f32x4){t[4], t[5], t[6], t[7]};
                               unpack8(*(const u32x4*)(VD + (size_t)b * KVW + g * 128 + i8), t); va = (f32x4){t[0], t[1], t[2], t[3]}; vb = (f32x4){t[4], t[5], t[6], t[7]}; } }
                    if (kk == 128 || !cvsplit) {
                    *(f32x4*)(ko + (size_t)(kk - 1) * KVW) = (f32x4){kf[0], kf[1], kf[2], kf[3]}; *(f32x4*)(ko + (size_t)(kk - 1) * KVW + 4) = (f32x4){kf[4], kf[5], kf[6], kf[7]};
                    *(f32x4*)(vo + (size_t)(kk - 1) * KVW) = (f32x4){vf[0], vf[1], vf[2], vf[3]}; *(f32x4*)(vo + (size_t)(kk - 1) * KVW + 4) = (f32x4){vf[4], vf[5], vf[6], vf[7]}; }
                    const float dist = (float)(128 - kk);
#pragma unroll
                    for (int hh = 0; hh < 4; ++hh) {
                        float d = 0.f;
#pragma unroll
                        for (int e = 0; e < 8; ++e) d += q[hh][e] * kf[e];
                        d = rowsum16(d);
                        const float sv = d * scale - slope[hh] * dist;
                        const float mn = fmaxf(m[hh], sv), al = __expf(m[hh] - mn), pp = __expf(sv - mn);
                        l[hh] = l[hh] * al + pp; m[hh] = mn;
#pragma unroll
                        for (int e = 0; e < 8; ++e) o[hh][e] = o[hh][e] * al + pp * vf[e];
                    }
                }
#pragma unroll
                for (int hh = 0; hh < 4; ++hh) {
                    const float M = xrow16_max(m[hh]);
                    const float f = __expf(m[hh] - M); const float lt = xrow16_sum(l[hh] * f);
                    const float inv = 1.f / lt; float oo[8];
#pragma unroll
                    for (int e = 0; e < 8; ++e) oo[e] = xrow16_sum(o[hh][e] * f) * inv;
                    if (r == 0) *(u32x4*)(QB + row * DM + (4 * g + hh) * 128 + i8) = pack8(oo);
                }
            }
        }
        {
            const float scale = 0.08838834764831845f;
            const int c = lane & 31, hq = lane >> 5;
            for (int unit = bx; unit < 64 * NKV; unit += G) {
                const int n = unit >> 3, g = unit & 7, tok0 = 128 * (n - 1);
                int t2 = tid; asm volatile("" : "+v"(t2));
                {
                    const int kj0 = t2 >> 4, c16 = t2 & 15;
                    const bf16_t* gk = KB + (size_t)(tok0 + kj0) * KVW + g * 128 + c16 * 8;
                    LAS unsigned char* lk = lds + kj0 * AT_KS + c16 * 16;
#pragma unroll
                    for (int i = 0; i < 8; ++i) { u32x4 v = (u32x4){0u, 0u, 0u, 0u}; if (n > 0 || i >= 4) v = *(const u32x4*)(gk + (size_t)i * 32 * KVW);
                        *(LAS u32x4*)(lk + i * 32 * AT_KS) = v; }
                    const int d0 = t2 >> 5, cc = t2 & 31;
                    const bf16_t* gv = VT + (size_t)(g * 128 + d0) * MP + tok0 + 8 * cc;
                    LAS unsigned char* lv = lds + AT_VO + d0 * AT_VS + cc * 16;
#pragma unroll
                    for (int i = 0; i < 8; ++i) { u32x4 v = (u32x4){0u, 0u, 0u, 0u}; if (n > 0 || cc >= 16) v = *(const u32x4*)(gv + (size_t)i * 16 * MP);
                        *(LAS u32x2*)(lv + i * 16 * AT_VS) = (u32x2){v.x, v.y}; *(LAS u32x2*)(lv + i * 16 * AT_VS + 8) = (u32x2){v.z, v.w}; }
                }
                __syncthreads();
                const int hh = wave >> 1, h = 4 * g + hh; const float slope = exp2f(-8.f * (float)(h + 1) / 32.f), sink = args.in[I_SINK][h];
#define ATT_QTILE(Qf, q0) do { const int kt0 = (q0) >> 5; bf16_t* qrow = QB + (size_t)(128 * n + (q0) + c) * DM + h * 128; \
                    f32x16 S[5]; \
                    const LAS unsigned char* kbase = lds + (32 * kt0 + c) * AT_KS + hq * 16; \
                    const LAS unsigned char* vbase = lds + AT_VO + c * AT_VS + kt0 * 64 + hq * 8; \
_Pragma("unroll") \
                    for (int t = 0; t < 5; ++t) { \
_Pragma("unroll") \
                        for (int r = 0; r < 16; ++r) S[t][r] = 0.f; \
_Pragma("unroll") \
                        for (int s = 0; s < 8; ++s) { const bf16x8 Kf = *(const LAS bf16x8*)(kbase + t * 32 * AT_KS + s * 32); \
                            S[t] = __builtin_amdgcn_mfma_f32_32x32x16_bf16(Kf, Qf[s], S[t], 0, 0, 0); } \
                        __builtin_amdgcn_sched_barrier(0); \
                    } \
                      \
                    int dbase = c - 4 * hq; asm volatile("" : "+v"(dbase));     \
                    const unsigned lim = n > 0 ? 128u : (unsigned)(q0 + c + 1); \
                    float mx = sink; \
_Pragma("unroll") \
                    for (int t = 0; t < 5; ++t) \
_Pragma("unroll") \
                        for (int r = 0; r < 16; ++r) { const int dist = dbase + (128 - 32 * t - (r & 3) - 8 * (r >> 2)); \
                            const float sv = ((unsigned)dist < lim) ? S[t][r] * scale - slope * (float)dist : -INFINITY; S[t][r] = sv; mx = fmaxf(mx, sv); } \
                    mx = fmaxf(mx, __shfl_xor(mx, 32)); \
                    float ls = 0.f; \
_Pragma("unroll") \
                    for (int t = 0; t < 5; ++t) \
_Pragma("unroll") \
                        for (int r = 0; r < 16; ++r) { const float pp = __expf(S[t][r] - mx); S[t][r] = pp; ls += pp; } \
                    ls += __shfl_xor(ls, 32); ls += __expf(sink - mx); \
                    u32x4 Pk[5][2]; \
_Pragma("unroll") \
                    for (int t = 0; t < 5; ++t) \
_Pragma("unroll") \
                        for (int s2 = 0; s2 < 2; ++s2) { \
                            Pk[t][s2].x = cvt_pk_bf16(S[t][8 * s2 + 0], S[t][8 * s2 + 1]); Pk[t][s2].y = cvt_pk_bf16(S[t][8 * s2 + 2], S[t][8 * s2 + 3]); \
                            Pk[t][s2].z = cvt_pk_bf16(S[t][8 * s2 + 4], S[t][8 * s2 + 5]); Pk[t][s2].w = cvt_pk_bf16(S[t][8 * s2 + 6], S[t][8 * s2 + 7]); } \
                    __builtin_amdgcn_sched_barrier(0); \
                    f32x16 O[4]; \
_Pragma("unroll") \
                    for (int dt = 0; dt < 4; ++dt) \
_Pragma("unroll") \
                        for (int r = 0; r < 16; ++r) O[dt][r] = 0.f; \
_Pragma("unroll") \
                    for (int t = 0; t < 5; ++t) \
_Pragma("unroll") \
                        for (int s2 = 0; s2 < 2; ++s2) { \
                            union { u32x4 u; bf16x8 b; } pf; pf.u = Pk[t][s2]; \
_Pragma("unroll") \
                            for (int dt = 0; dt < 4; ++dt) { \
                                const u32x2 vlo = *(const LAS u32x2*)(vbase + dt * 32 * AT_VS + t * 64 + s2 * 32), vhi = *(const LAS u32x2*)(vbase + dt * 32 * AT_VS + t * 64 + s2 * 32 + 16); \
                                union { u32x4 u; bf16x8 b; } vf; vf.u = (u32x4){vlo.x, vlo.y, vhi.x, vhi.y}; \
                                O[dt] = __builtin_amdgcn_mfma_f32_32x32x16_bf16(vf.b, pf.b, O[dt], 0, 0, 0); } \
                            __builtin_amdgcn_sched_barrier(0); \
                        } \
                    const float inv = 1.f / ls; \
_Pragma("unroll") \
                    for (int dt = 0; dt < 4; ++dt) \
_Pragma("unroll") \
                        for (int gp = 0; gp < 2; ++gp) {         \
                            u32x2 a, b; \
                            a.x = cvt_pk_bf16(O[dt][8 * gp] * inv, O[dt][8 * gp + 1] * inv); a.y = cvt_pk_bf16(O[dt][8 * gp + 2] * inv, O[dt][8 * gp + 3] * inv); \
                            b.x = cvt_pk_bf16(O[dt][8 * gp + 4] * inv, O[dt][8 * gp + 5] * inv); b.y = cvt_pk_bf16(O[dt][8 * gp + 6] * inv, O[dt][8 * gp + 7] * inv); \
                            { auto r = __builtin_amdgcn_permlane32_swap(a.x, b.x, false, false); a.x = r[0]; b.x = r[1]; } \
                            { auto r = __builtin_amdgcn_permlane32_swap(a.y, b.y, false, false); a.y = r[0]; b.y = r[1]; } \
                            *(u32x4*)(qrow + 32 * dt + 16 * gp + 8 * hq) = (u32x4){a.x, a.y, b.x, b.y}; } \
                } while (0)
                {
                    const int qa = (wave & 1) * 64, qb = qa + 32;
                    bf16x8 QfA[8], QfB[8];
                    const bf16_t* qra = QB + (size_t)(128 * n + qa + c) * DM + h * 128 + 8 * hq; const bf16_t* qrb = qra + (size_t)32 * DM;
#pragma unroll
                    for (int s_ = 0; s_ < 8; ++s_) QfA[s_] = *(const bf16x8*)(qra + 16 * s_);
#pragma unroll
                    for (int s_ = 0; s_ < 8; ++s_) QfB[s_] = *(const bf16x8*)(qrb + 16 * s_);
                    ATT_QTILE(QfA, qa);
                    __builtin_amdgcn_sched_barrier(0);
                    ATT_QTILE(QfB, qb);
                }
#undef ATT_QTILE
                __syncthreads();
            }
        }
    }
    SEAM(4);
    if (IN(5)) {
        pg8::Gemm g{XC, WGT, DM, 256, 256, 128, 128, 0, 0}; pg8::Order<1> S; S.init(32, 32, 32, G, bx);
        EpiGates E{AU, XC, args.in[I_RBA], args.in[I_RBX], LC};
        pg8::gemm_phase(lds, g, S, E);
    }
    SEAM(5);
    if (IN(6)) {
        for (int wt = wave * G + bx; wt < NCH * 16; wt += 8 * G) {
            const int j = wt >> 4, ch4 = ((wt & 15) * 64 + lane) * 4; const size_t base = (size_t)j * CHR * DM + ch4;
            float Sl[4] = {0.f, 0.f, 0.f, 0.f}, Hh[4] = {0.f, 0.f, 0.f, 0.f};
#pragma unroll 16
            for (int t = 0; t < CHR; ++t) { const u32x4 w = *(const u32x4*)(AU + base + (size_t)t * DM);
#pragma unroll
                for (int k = 0; k < 4; ++k) { const float l2 = bf_lo(w[k]); Hh[k] = __builtin_amdgcn_exp2f(l2) * Hh[k] + bf_hi(w[k]); Sl[k] += l2; } }
            *(f32x4*)(CP + j * DM + ch4) = (f32x4){__builtin_amdgcn_exp2f(Sl[0]), __builtin_amdgcn_exp2f(Sl[1]), __builtin_amdgcn_exp2f(Sl[2]), __builtin_amdgcn_exp2f(Sl[3])};
            *(f32x4*)(CH + j * DM + ch4) = (f32x4){Hh[0], Hh[1], Hh[2], Hh[3]};
        }
    }
    SEAM(6);
    if (IN(7)) {
        for (int wt = wave * G + bx; wt < NCH * 16; wt += 8 * G) {
            const int j = wt >> 4, ch4 = ((wt & 15) * 64 + lane) * 4; const size_t base = (size_t)j * CHR * DM + ch4;
            float h[4] = {0.f, 0.f, 0.f, 0.f};
            for (int j0 = 0; j0 < j; j0 += 16) {
                f32x4 cp[16], cq[16];
#pragma unroll
                for (int e = 0; e < 16; ++e) if (j0 + e < j) { cp[e] = *(const f32x4*)(CP + (j0 + e) * DM + ch4); cq[e] = *(const f32x4*)(CH + (j0 + e) * DM + ch4); }
#pragma unroll
                for (int e = 0; e < 16; ++e) if (j0 + e < j) {
#pragma unroll
                    for (int k = 0; k < 4; ++k) h[k] = cp[e][k] * h[k] + cq[e][k]; }
            }
#pragma unroll 16
            for (int t = 0; t < CHR; ++t) { const size_t o = base + (size_t)t * DM; const u32x4 w = *(const u32x4*)(AU + o); const u32x2 y = *(const u32x2*)(YG + o);
#pragma unroll
                for (int k = 0; k < 4; ++k) h[k] = __builtin_amdgcn_exp2f(bf_lo(w[k])) * h[k] + bf_hi(w[k]);
                u32x2 r; r.x = cvt_pk_bf16(h[0] * bf_lo(y.x), h[1] * bf_hi(y.x)); r.y = cvt_pk_bf16(h[2] * bf_lo(y.y), h[3] * bf_hi(y.y)); *(u32x2*)(YG + o) = r; }
            if (j == NCH - 1) *(f32x4*)(out + O_PH + ch4) = (f32x4){h[0], h[1], h[2], h[3]};
        }
        const float* sh = args.in[I_SH];
        for (int e = bx * 512 + tid; e < NBD * DM; e += G * 512) {
            const size_t o = (size_t)TP * DM + e; const unsigned w = AU[o]; const float h = __builtin_amdgcn_exp2f(bf_lo(w)) * sh[e] + bf_hi(w);
            out[O_SH + e] = h; YG[o] = (bf16_t)(cvt_pk_bf16(h * bf2f(YG[o]), 0.f) & 0xffffu);
        }
    }
    SEAM(7);
    if (IN(8)) {
        {
            if ((32 * (DM / 256)) % G == 0) {
            pg8::Gemm g{YG, WL, DM, DM, DM, 128, 128, (size_t)((const char*)QB - (const char*)YG), (size_t)((const char*)WA - (const char*)WL)}; pg8::Order<5> S; S.init(32, DM / 256, 0, G, bx);
            EpiProj E{GR, GA, MIX, 0}; pg8::gemm_phase(lds, g, S, E);
            } else {
            { pg8::Gemm g{YG, WL, DM, DM, DM, 128, 128, 0, 0}; pg8::Order<0> S; S.init(32, DM / 256, 0, G, bx); EpiProj E{GR, GA, MIX, 0}; pg8::gemm_phase(lds, g, S, E); }
            asm volatile("s_waitcnt vmcnt(0)" ::: "memory");
            { pg8::Gemm g{QB, WA, DM, DM, DM, 128, 128, 0, 0}; pg8::Order<0> S; S.init(32, DM / 256, 0, G, bx); EpiProj E{GR, GA, MIX, 1}; pg8::gemm_phase(lds, g, S, E); }
            } }
        {
            LAS float* p1 = (LAS float*)lds; LAS float* p2 = p1 + 8 * 64 * 32;
            for (int unit = bx; unit < 2 * (DM / 32); unit += G) {
                const int r0 = 64 * (unit & 1), n0 = 32 * (unit >> 1);
                f32x4 acc[4][2]; skinny_zero(acc);
                skinny_acc(YG + (size_t)(TP + r0) * DM, DM, WL + (size_t)n0 * DM, DM, wave * (DM / 8), DM / 256, acc, lane);
                skinny_store(p1, acc, wave, lane);
                skinny_zero(acc);
                skinny_acc(QB + (size_t)(TP + r0) * DM, DM, WA + (size_t)n0 * DM, DM, wave * (DM / 8), DM / 256, acc, lane);
                skinny_store(p2, acc, wave, lane);
                __syncthreads();
                const int rowl = tid >> 3, c4 = tid & 7; const size_t off = (size_t)(TP + r0 + rowl) * DM + n0 + 4 * c4;
                const f32x4 s1 = skinny_sum(p1, rowl, c4), s2 = skinny_sum(p2, rowl, c4);
                const u32x2 gr = *(const u32x2*)(GR + off), ga = *(const u32x2*)(GA + off);
                u32x2 w; w.x = cvt_pk_bf16(bf_lo(gr.x) * s1[0] + bf_lo(ga.x) * s2[0], bf_hi(gr.x) * s1[1] + bf_hi(ga.x) * s2[1]);
                w.y = cvt_pk_bf16(bf_lo(gr.y) * s1[2] + bf_lo(ga.y) * s2[2], bf_hi(gr.y) * s1[3] + bf_hi(ga.y) * s2[3]);
                *(u32x2*)(MIX + off) = w;
                __syncthreads();
            }
        }
    }
    SEAM(8);
    if (IN(9)) {
        pg8::Gemm g{MIX, WO, DM, DM, DM, 128, 128, 0, 0}; pg8::Order<0> S; S.init(32, DM / 256, 0, G, bx);
        EpiResid<1> E{nullptr, XB, nullptr, SS2, 1.0f};
        pg8::gemm_phase(lds, g, S, E);
        skinny_resid<1, false>(lds, MIX + (size_t)TP * DM, DM, WO, DM, nullptr, XB, SS2, nullptr, 1.0f, G, bx, tid, wave, lane);
    }
    SEAM(9);
    if (IN(10)) {
        if (cvsplit && bx >= CVG1) {
            convert_items(args, ws, lds, R_WD2, R_WIN, (bx - CVG1) * 8 + wave, (G - CVG1) * 8, wave, lane);
            {
                const int nth = (G - CVG1) * 512, th = (bx - CVG1) * 512 + tid; constexpr int RUN4 = 127 * KVW / 4;
                for (int kv = 0; kv < 2; ++kv) {
                    const float* src = args.in[kv ? I_CV : I_CK]; float* dst = out + (kv ? O_SV : O_SK);
                    for (int i0 = th; i0 < NBD * RUN4; i0 += 8 * nth) {
                        f32x4 v[8];
#pragma unroll
                        for (int e = 0; e < 8; ++e) { const int i = i0 + e * nth; if (i < NBD * RUN4) { const int b = i / RUN4, r = i - b * RUN4; v[e] = *(const f32x4*)(src + (size_t)b * 128 * KVW + KVW + 4 * (size_t)r); } }
#pragma unroll
                        for (int e = 0; e < 8; ++e) { const int i = i0 + e * nth; if (i < NBD * RUN4) { const int b = i / RUN4, r = i - b * RUN4; *(f32x4*)(dst + (size_t)b * 128 * KVW + 4 * (size_t)r) = v[e]; } }
                    }
                }
            }
        } else {
        pg8::Gemm g{XB, WGU2, DM, DM, DM, 128, 128, 0, 0}; pg8::Order<0> S; S.init(32, 2 * FF / 256, 2 * FF / 256, cvsplit ? CVG1 : G, bx);
        EpiSwiglu E{HB, SS2};
        pg8::gemm_phase(lds, g, S, E);
        }
    }
    SEAM(10);
    if (IN(11)) {
        pg8::Gemm g{HB, WD2, 64, 64, FF, (size_t)MP * 128, (size_t)DM * 128, 0, 0};   pg8::Order<0> S; S.init(32, DM / 256, 0, G, bx);
        EpiResid<2> E{nullptr, XB, out, nullptr, 0.5f};
        pg8::gemm_phase(lds, g, S, E);
        skinny_resid<2, true>(lds, HB + (size_t)TP * 64, 64, WD2, FF, nullptr, XB, nullptr, out, 0.5f, G, bx, tid, wave, lane);
    }
#undef IN
#undef SEAM
}

extern "C" void kernel_launch(void* const* d_in, const int* in_sizes, int n_in, void* d_out, int out_size, void* d_ws, size_t ws_size, hipStream_t stream) {
    static int grid = 0;
    if (grid == 0) {
        if (n_in != 29 || (size_t)out_size != O_END || ws_size < WS_END) { fprintf(stderr, "kernel_launch: unexpected shapes: n_in %d out %d (want %zu) ws %zu (need %zu)\n", n_in, out_size, (size_t)O_END, ws_size, (size_t)WS_END); grid = -1; return; }
        int dev = 0, cus = 0, per_cu = 0;
        if (hipGetDevice(&dev) != hipSuccess || hipDeviceGetAttribute(&cus, hipDeviceAttributeMultiprocessorCount, dev) != hipSuccess) { grid = -1; return; }
        if (hipFuncSetAttribute((const void*)mk_fwd, hipFuncAttributeMaxDynamicSharedMemorySize, LDS_BYTES) != hipSuccess) { fprintf(stderr, "kernel_launch: hipFuncSetAttribute failed\n"); grid = -1; return; }
        if (hipOccupancyMaxActiveBlocksPerMultiprocessor(&per_cu, (const void*)mk_fwd, 512, LDS_BYTES) != hipSuccess || per_cu < 1) fprintf(stderr, "kernel_launch: occupancy query reports %d\n", per_cu);
        (void)hipGetLastError();
        grid = cus;
    }
    if (grid < 0) return;
    (void)hipMemsetAsync((char*)d_ws + WS_CTL, 0, CTL_ZERO_BYTES, stream);
    Args a{};
    for (int i = 0; i < 29; ++i) a.in[i] = (const float*)d_in[i];
    a.out = (float*)d_out; a.ws = (unsigned char*)d_ws;
#if MK_PER_PHASE
    for (int p = 0; p < NPHASE; ++p) { a.ph_lo = p; a.ph_hi = p + 1; hipLaunchKernelGGL(mk_fwd, dim3(grid), dim3(512), LDS_BYTES, stream, a); }
#else
    a.ph_lo = 0; a.ph_hi = NPHASE;
    hipLaunchKernelGGL(mk_fwd, dim3(grid), dim3(512), LDS_BYTES, stream, a);
#endif
    const hipError_t le = hipPeekAtLastError();
    if (le != hipSuccess) fprintf(stderr, "kernel_launch: launch failed: %s\n", hipGetErrorName(le));
}
```

```cpp
#include <hip/hip_runtime.h>
#include <cstdio>
#include <cstdint>

#ifndef MK_PER_PHASE
#define MK_PER_PHASE 0
#endif

#define GAS __attribute__((address_space(1)))
#define LAS __attribute__((address_space(3)))
typedef unsigned short bf16_t;
typedef short bf16x8 __attribute__((ext_vector_type(8)));
typedef float f32x2 __attribute__((ext_vector_type(2)));
typedef float f32x4 __attribute__((ext_vector_type(4)));
typedef float f32x16 __attribute__((ext_vector_type(16)));
typedef unsigned u32x4 __attribute__((ext_vector_type(4)));
typedef unsigned u32x2 __attribute__((ext_vector_type(2)));

constexpr int DM = 4096, FF = 11008, TP = 8192, NBD = 128, MV = TP + NBD, MP = 8448, NPAN = MP / 256;
constexpr int NQH = 32, NKV = 8, HD = 128, KVW = NKV * HD, INC = 22528;
constexpr float EPS = 1e-6f;
constexpr int NPHASE = 12;

__device__ __forceinline__ unsigned cvt_pk_bf16(float lo, float hi) { unsigned r; asm volatile("v_cvt_pk_bf16_f32 %0, %1, %2" : "=v"(r) : "v"(lo), "v"(hi)); return r; }
__device__ __forceinline__ float bf_lo(unsigned w) { return __uint_as_float(w << 16); }
__device__ __forceinline__ float bf_hi(unsigned w) { return __uint_as_float(w & 0xffff0000u); }
__device__ __forceinline__ float bf2f(bf16_t b) { return __uint_as_float(((unsigned)b) << 16); }
__device__ __forceinline__ float rsq(float x) { return __builtin_amdgcn_rsqf(x); }
__device__ __forceinline__ float rcp(float x) { return __builtin_amdgcn_rcpf(x); }
__device__ __forceinline__ float sigm(float x) { return rcp(1.f + __expf(-x)); }
__device__ __forceinline__ float sig1(float v, float c1, float c2, float k0, float k1) { const float sg = sigm(v * (c1 + c2 * (v * v))); return sg * (k0 + k1 * v); }
__device__ __forceinline__ float gelu_tanh(float x) { return x * sigm(1.5957691216057308f * (x + 0.044715f * x * x * x)); }
__device__ __forceinline__ void unpack8(const u32x4 w, float (&o)[8]) { o[0] = bf_lo(w.x); o[1] = bf_hi(w.x); o[2] = bf_lo(w.y); o[3] = bf_hi(w.y); o[4] = bf_lo(w.z); o[5] = bf_hi(w.z); o[6] = bf_lo(w.w); o[7] = bf_hi(w.w); }
__device__ __forceinline__ u32x4 pack8(const float (&o)[8]) { u32x4 w; w.x = cvt_pk_bf16(o[0], o[1]); w.y = cvt_pk_bf16(o[2], o[3]); w.z = cvt_pk_bf16(o[4], o[5]); w.w = cvt_pk_bf16(o[6], o[7]); return w; }

template <int CTRL> __device__ __forceinline__ float dpp_mov(float x) { return __int_as_float(__builtin_amdgcn_update_dpp(0, __float_as_int(x), CTRL, 0xF, 0xF, false)); }
__device__ __forceinline__ float xrow16_sum(float x) {
    auto s = __builtin_amdgcn_permlane16_swap(__float_as_uint(x), __float_as_uint(x), false, false); x = __uint_as_float(s[0]) + __uint_as_float(s[1]);
    auto t = __builtin_amdgcn_permlane32_swap(__float_as_uint(x), __float_as_uint(x), false, false); return __uint_as_float(t[0]) + __uint_as_float(t[1]);
}
__device__ __forceinline__ float xrow16_max(float x) {
    auto s = __builtin_amdgcn_permlane16_swap(__float_as_uint(x), __float_as_uint(x), false, false); x = fmaxf(__uint_as_float(s[0]), __uint_as_float(s[1]));
    auto t = __builtin_amdgcn_permlane32_swap(__float_as_uint(x), __float_as_uint(x), false, false); return fmaxf(__uint_as_float(t[0]), __uint_as_float(t[1]));
}
__device__ __forceinline__ float rowsum16(float x) { x += dpp_mov<0xB1>(x); x += dpp_mov<0x4E>(x); x += dpp_mov<0x141>(x); x += dpp_mov<0x140>(x); return x; }
namespace pg8 {
constexpr int BM = 256, BK = 64, HALF = 128, HTB = HALF * BK * 2, STAGE_BYTES = 8 * HTB, NXCD = 8, WGM = 8;
__host__ __device__ __forceinline__ int lds_byte(int r, int c) { const int st = (r >> 4) * 2 + (c >> 5), rr = r & 15, cc = c & 31, ob = rr * 64 + cc * 2; return st * 1024 + (ob ^ (((ob >> 9) & 1) << 5)); }
__host__ __device__ __forceinline__ void stage_rc(int b, int& R, int& C) { const int st = b / 1024, sb = b % 1024, swz = sb ^ (((sb >> 9) & 1) << 5); R = (st >> 1) * 16 + swz / 64; C = (st & 1) * 32 + (swz % 64) / 2; }
__host__ __device__ __forceinline__ int perm32(int rho) { const int n = rho >> 4, i = rho & 15; return 8 * (i >> 2) + 4 * n + (i & 3); }

struct Unit { int pm, pn, half; };
struct Gemm { const bf16_t* A; const bf16_t* Bt; int lda, ldb, K; size_t ksA, ksB, dA, dB; };

template <int MODE> struct Order {
    int nM, nN, nwg, G, c, nH, rem, nShort, myFull;
    __device__ void init(int nM_, int nN_, int nH_, int G_, int c_) { nM = nM_; nN = nN_; nwg = nM * nN; G = G_; c = c_; nH = nH_; const int tot = MODE == 5 ? 2 * nwg : nwg; rem = tot % G; myFull = tot / G + (c < rem ? 1 : 0); nShort = rem ? G - rem : G; }
    __device__ bool next(int i, Unit& u) const {
        if (i >= myFull) {
            if (nH == 0) return false;
            const int s = rem ? c - rem : c; if (s < 0) return false;
            const int h = s + (i - myFull) * nShort; if (h >= nH) return false;
            u.pm = nM; u.pn = h; u.half = 1; return true;
        }
        int wgid = i * G + c; int kind2 = 0; if (MODE == 5 && wgid >= nwg) { wgid -= nwg; kind2 = 2; }
        { const int q = nwg / NXCD, r = nwg % NXCD, xcd = wgid % NXCD, off = wgid / NXCD; wgid = (xcd < r ? xcd * (q + 1) : r * (q + 1) + (xcd - r) * q) + off; }
        const int nig = WGM * nN, gid = wgid / nig, fm = gid * WGM, gsz = (nM - fm) < WGM ? (nM - fm) : WGM;
        u.pm = fm + ((wgid % nig) % gsz); u.pn = (wgid % nig) / gsz; u.half = kind2;
        if (MODE == 2 && u.pn >= 52) u.pn += 4;
        return true;
    }
    __device__ __forceinline__ size_t a_off(const Unit& u, const Gemm& g) const { size_t o = (size_t)u.pm * 256 * g.lda * 2; if (MODE == 1) o += (size_t)(u.pn >> 1) * 512; if (MODE == 5 && u.half == 2) o += g.dA; return o; }
    __device__ __forceinline__ size_t b_off(const Unit& u, const Gemm& g) const { return (size_t)u.pn * 256 * g.ldb * 2 + ((MODE == 5 && u.half == 2) ? g.dB : 0); }
};

template <class Epi, class Sched>
__device__ __forceinline__ void gemm_phase(LAS unsigned char* lds, const Gemm g, const Sched& S, const Epi& E) {
    const int tid = threadIdx.x, wid = __builtin_amdgcn_readfirstlane(tid >> 6), lane = tid & 63, wr = wid >> 2, wc = wid & 3, fr = lane & 15, fq = lane >> 4;
    int K = g.K; asm volatile("" : "+s"(K));
    const int nt = K / BK;
    unsigned voffA[2], voffB[2];
#pragma unroll
    for (int i = 0; i < 2; ++i) { int R, C; stage_rc(tid * 16 + i * 8192, R, C); const int Rb = (R & ~31) + perm32(R & 31);
        voffA[i] = (unsigned)(R * g.lda + C) * 2u; voffB[i] = (unsigned)(Rb * g.ldb + C) * 2u; }
    const size_t kstepA = g.ksA, kstepB = g.ksB;
    const size_t hstepA = (size_t)HALF * g.lda * 2, hstepB = (size_t)HALF * g.ldb * 2;
    const unsigned ldsw = (unsigned)wid * 1024u;
    const int aoff = lds_byte(wr * 64 + fr, fq * 8), boff = lds_byte(wc * 32 + fr, fq * 8);
#define PG8_SA(b, h) (((b) * 2 + (h)) * HTB)
#define PG8_SB(b, h) ((4 + (b) * 2 + (h)) * HTB)
#define PG8_STAGE(bufoff, gbase, voff) do { _Pragma("unroll") for (int _i = 0; _i < 2; ++_i) \
        __builtin_amdgcn_global_load_lds((const unsigned*)((const char*)(gbase) + (voff)[_i]), (LAS unsigned*)(lds + (bufoff) + ldsw + _i * 8192), 16, 0, 0); } while (0)
#define PG8_LDA(dst, b, h) do { _Pragma("unroll") for (int m = 0; m < 4; ++m) _Pragma("unroll") for (int k = 0; k < 2; ++k) dst[m][k] = *(const LAS bf16x8*)(lds + PG8_SA(b, h) + aoff + m * 2048 + k * 1024); } while (0)
#define PG8_LDB(dst, b, h) do { _Pragma("unroll") for (int n = 0; n < 2; ++n) _Pragma("unroll") for (int k = 0; k < 2; ++k) dst[n][k] = *(const LAS bf16x8*)(lds + PG8_SB(b, h) + boff + n * 2048 + k * 1024); } while (0)
#define PG8_MMA(ai, bj, At, Bt) do { __builtin_amdgcn_s_setprio(1); _Pragma("unroll") for (int m = 0; m < 4; ++m) _Pragma("unroll") for (int n = 0; n < 2; ++n) _Pragma("unroll") for (int k = 0; k < 2; ++k) \
        acc[ai][bj][m][n] = __builtin_amdgcn_mfma_f32_16x16x32_bf16(Bt[n][k], At[m][k], acc[ai][bj][m][n], 0, 0, 0); __builtin_amdgcn_s_setprio(0); } while (0)
#define PG8_WAIT_V(n) asm volatile("s_waitcnt vmcnt(" #n ")" ::: "memory")
#define PG8_WAIT_L(n) asm volatile("s_waitcnt lgkmcnt(" #n ")" ::: "memory")
#define PG8_BAR __builtin_amdgcn_s_barrier()
#define PG8_SCHED __builtin_amdgcn_sched_barrier(0)
    Unit cur, nxt; int ui = 0;
    if (!S.next(0, cur)) return;
    f32x4 acc[2][2][4][2];
#pragma unroll
    for (int a = 0; a < 2; ++a)
#pragma unroll
        for (int b = 0; b < 2; ++b)
#pragma unroll
            for (int m = 0; m < 4; ++m)
#pragma unroll
                for (int n = 0; n < 2; ++n) acc[a][b][m][n] = (f32x4){0.f, 0.f, 0.f, 0.f};
    bf16x8 At[4][2], B0[2][2], B1[2][2];
    const char* cA = (const char*)g.A + S.a_off(cur, g); const char* cB = (const char*)g.Bt + S.b_off(cur, g);
    PG8_STAGE(PG8_SB(0, 0), cB, voffB); PG8_STAGE(PG8_SB(0, 1), cB + hstepB, voffB); PG8_STAGE(PG8_SA(0, 0), cA, voffA); PG8_STAGE(PG8_SA(0, 1), cA + hstepA, voffA);
    if (wr == 1) PG8_BAR;
    PG8_WAIT_V(2); PG8_BAR;
    PG8_STAGE(PG8_SB(1, 0), cB + kstepB, voffB); PG8_STAGE(PG8_SA(1, 0), cA + kstepA, voffA); PG8_STAGE(PG8_SB(1, 1), cB + hstepB + kstepB, voffB);
    PG8_WAIT_V(6); PG8_BAR;
    for (;;) {
        const bool has_next = S.next(ui + 1, nxt);
        float pre[8]; E.prefetch(pre, cur, wr, fr);
        const char* nA = has_next ? (const char*)g.A + S.a_off(nxt, g) : cA; const char* nB = has_next ? (const char*)g.Bt + S.b_off(nxt, g) : cB;
#define PG8_KLOOP(FULL) \
        for (int t = 0; t < nt; t += 2) { \
            const bool last = (t == nt - 2); \
            const char* a1 = cA + (size_t)(t + 1) * kstepA; \
            const char* a2 = last ? nA : cA + (size_t)(t + 2) * kstepA; const char* b2 = last ? nB : cB + (size_t)(t + 2) * kstepB; \
            const char* a3 = a2 + kstepA; const char* b3 = b2 + kstepB; \
              \
            PG8_LDB(B0, 0, 0); PG8_LDB(B1, 0, 1); PG8_SCHED; PG8_LDA(At, 0, 0); PG8_STAGE(PG8_SA(1, 1), a1 + hstepA, voffA); \
            PG8_WAIT_V(8); PG8_WAIT_L(0); PG8_BAR; PG8_MMA(0, 0, At, B0); PG8_MMA(0, 1, At, B1); PG8_BAR; PG8_SCHED; \
              \
            if (FULL) PG8_LDA(At, 0, 1); PG8_STAGE(PG8_SB(0, 0), b2, voffB); PG8_STAGE(PG8_SB(0, 1), b2 + hstepB, voffB); PG8_STAGE(PG8_SA(0, 0), a2, voffA); \
            PG8_WAIT_V(8); PG8_WAIT_L(0); PG8_BAR; if (FULL) { PG8_MMA(1, 0, At, B0); PG8_MMA(1, 1, At, B1); } PG8_BAR; PG8_SCHED; \
              \
            PG8_LDB(B0, 1, 0); PG8_LDB(B1, 1, 1); PG8_SCHED; PG8_LDA(At, 1, 0); PG8_STAGE(PG8_SA(0, 1), a2 + hstepA, voffA); \
            PG8_WAIT_V(8); PG8_WAIT_L(0); PG8_BAR; PG8_MMA(0, 0, At, B0); PG8_MMA(0, 1, At, B1); PG8_BAR; PG8_SCHED; \
              \
            if (FULL) PG8_LDA(At, 1, 1); PG8_STAGE(PG8_SB(1, 0), b3, voffB); PG8_STAGE(PG8_SB(1, 1), b3 + hstepB, voffB); PG8_STAGE(PG8_SA(1, 0), a3, voffA); \
            PG8_WAIT_V(8); PG8_WAIT_L(0); PG8_BAR; if (FULL) { PG8_MMA(1, 0, At, B0); PG8_MMA(1, 1, At, B1); } PG8_BAR; PG8_SCHED; \
        }
        if (cur.half != 1) { PG8_KLOOP(1) } else { PG8_KLOOP(0) }
#undef PG8_KLOOP
        if (wr == 0) PG8_BAR;
        E(acc, cur, wr, wc, fr, fq, lds + STAGE_BYTES, pre);
        if (!has_next) break;
#pragma unroll
        for (int a = 0; a < 2; ++a)
#pragma unroll
            for (int b = 0; b < 2; ++b)
#pragma unroll
                for (int m = 0; m < 4; ++m)
#pragma unroll
                    for (int n = 0; n < 2; ++n) acc[a][b][m][n] = (f32x4){0.f, 0.f, 0.f, 0.f};
        cur = nxt; cA = nA; cB = nB; ++ui;
        if (wr == 1) PG8_BAR;
    }
    PG8_WAIT_V(0);
    PG8_BAR;
#undef PG8_SA
#undef PG8_SB
#undef PG8_STAGE
#undef PG8_LDA
#undef PG8_LDB
#undef PG8_MMA
#undef PG8_WAIT_V
#undef PG8_WAIT_L
#undef PG8_BAR
#undef PG8_SCHED
}
}
using pg8::Unit;

#define EPI_ARGS const f32x4 (&acc)[2][2][4][2], const Unit& u, int wr, int wc, int fr, int fq, LAS unsigned char* xl, const float (&pre)[8]
#define EPI_NO_PREFETCH __device__ __forceinline__ void prefetch(float (&pre)[8], const Unit&, int, int) const { _Pragma("unroll") for (int i = 0; i < 8; ++i) pre[i] = 0.f; }
#define EPI_SS_PREFETCH __device__ __forceinline__ void prefetch(float (&pre)[8], const Unit& u, int wr, int fr) const { const int row0 = u.pm * 256 + wr * 64 + fr; \
    _Pragma("unroll") for (int ai = 0; ai < 2; ++ai) _Pragma("unroll") for (int m = 0; m < 4; ++m) pre[ai * 4 + m] = ss[row0 + ai * 128 + m * 16]; }

struct EpiSwiglu {
    bf16_t* H; const float* ss;
    EPI_SS_PREFETCH
    __device__ __forceinline__ void operator()(EPI_ARGS) const {
        const int row0 = u.pm * 256 + wr * 64 + fr, col0 = u.pn * 128 + wc * 32 + 8 * fq;
#pragma unroll
        for (int ai = 0; ai < 2; ++ai) if (!(ai == 1 && u.half == 1))
#pragma unroll
            for (int m = 0; m < 4; ++m) {
                const int row = row0 + ai * 128 + m * 16; const float rs = rsq(pre[ai * 4 + m] * (1.f / DM) + EPS);
                float o[8];
#pragma unroll
                for (int n = 0; n < 2; ++n)
#pragma unroll
                    for (int j = 0; j < 4; ++j) { const float gg = acc[ai][0][m][n][j] * rs, uu = acc[ai][1][m][n][j] * rs; o[4 * n + j] = gg * sigm(gg) * uu; }
                *(u32x4*)(H + ((size_t)(col0 >> 6) * MP + row) * 64 + (col0 & 63)) = pack8(o);
            }
    }
};
template <int MODE> struct EpiResid {
    EPI_NO_PREFETCH
    const float* Xin; bf16_t* XB; float* out; float* ssn; float sc;
    __device__ __forceinline__ void operator()(EPI_ARGS) const {
        const int row0 = u.pm * 256 + wr * 64 + fr, col0 = u.pn * 256 + wc * 32 + 8 * fq;
#pragma unroll
        for (int ai = 0; ai < 2; ++ai) if (!(ai == 1 && u.half == 1)) {
            f32x4 xf[4][2][2]; u32x4 xb[4][2];
#pragma unroll
            for (int m = 0; m < 4; ++m)
#pragma unroll
                for (int bj = 0; bj < 2; ++bj) { const size_t off = (size_t)(row0 + ai * 128 + m * 16) * DM + col0 + bj * 128;
                    if (MODE == 0) { xf[m][bj][0] = *(const f32x4*)(Xin + off); xf[m][bj][1] = *(const f32x4*)(Xin + off + 4); } else xb[m][bj] = *(const u32x4*)(XB + off); }
            asm volatile("" ::: "memory");
#pragma unroll
            for (int m = 0; m < 4; ++m) {
                const int row = row0 + ai * 128 + m * 16; float q = 0.f;
#pragma unroll
                for (int bj = 0; bj < 2; ++bj) {
                    const size_t off = (size_t)row * DM + col0 + bj * 128;
                    f32x4 x0, x1;
                    if (MODE == 0) { x0 = xf[m][bj][0]; x1 = xf[m][bj][1]; }
                    else { float t[8]; unpack8(xb[m][bj], t); x0 = (f32x4){t[0], t[1], t[2], t[3]}; x1 = (f32x4){t[4], t[5], t[6], t[7]}; }
                    const f32x4 v0 = x0 + acc[ai][bj][m][0] * sc, v1 = x1 + acc[ai][bj][m][1] * sc;
                    if (MODE == 2) { if (row < MV) { *(f32x4*)(out + off) = v0; *(f32x4*)(out + off + 4) = v1; } }
                    else {
                        u32x4 w; w.x = cvt_pk_bf16(v0[0], v0[1]); w.y = cvt_pk_bf16(v0[2], v0[3]); w.z = cvt_pk_bf16(v1[0], v1[1]); w.w = cvt_pk_bf16(v1[2], v1[3]);
                        *(u32x4*)(XB + off) = w;
                        q += (v0[0] * v0[0] + v0[1] * v0[1]) + (v0[2] * v0[2] + v0[3] * v0[3]) + (v1[0] * v1[0] + v1[1] * v1[1]) + (v1[2] * v1[2] + v1[3] * v1[3]);
                    }
                }
                if (MODE != 2) { q = xrow16_sum(q); if (fq == 0) __hip_atomic_fetch_add(ssn + row, q, __ATOMIC_RELAXED, __HIP_MEMORY_SCOPE_AGENT); }
            }
        }
    }
};
struct EpiWin {
    EPI_SS_PREFETCH
    bf16_t *XR, *YG, *Q, *KB, *VD, *GR, *GA; const float* ss; const float *qg, *kg;
    __device__ __forceinline__ void operator()(EPI_ARGS) const {
        const int pn = u.pn; int mode, ld, cb; bf16_t* dst;
        if (pn < 16) { mode = 0; dst = XR; ld = DM; cb = pn * 256; }
        else if (pn < 32) { mode = 1; dst = YG; ld = DM; cb = (pn - 16) * 256; }
        else if (pn < 48) { mode = 2; dst = Q; ld = DM; cb = (pn - 32) * 256; }
        else if (pn < 52) { mode = 2; dst = KB; ld = KVW; cb = (pn - 48) * 256; }
        else if (pn < 56) { mode = 0; dst = VD - (size_t)TP * KVW; ld = KVW; cb = (pn - 52) * 256; }
        else if (pn < 72) { mode = 3; dst = GR; ld = DM; cb = (pn - 56) * 256; }
        else { mode = 3; dst = GA; ld = DM; cb = (pn - 72) * 256; }
        const int rl0 = wr * 64 + fr, row0 = u.pm * 256 + rl0, col0 = cb + wc * 32 + 8 * fq;
        float rsv[2][4];
#pragma unroll
        for (int ai = 0; ai < 2; ++ai) if (!(ai == 1 && u.half == 1))
#pragma unroll
            for (int m = 0; m < 4; ++m) rsv[ai][m] = rsq(pre[ai * 4 + m] * (1.f / DM) + EPS);
        if (mode == 2) {
            LAS float* XL = (LAS float*)xl;
            const float* gp = (pn < 48 ? qg : kg) + wc * 32 + 8 * fq;
            float gv[8];
#pragma unroll
            for (int j = 0; j < 8; ++j) gv[j] = gp[j];
#pragma unroll
            for (int ai = 0; ai < 2; ++ai) if (!(ai == 1 && u.half == 1))
#pragma unroll
                for (int m = 0; m < 4; ++m)
#pragma unroll
                    for (int bj = 0; bj < 2; ++bj) {
                        const f32x4 a0 = acc[ai][bj][m][0], a1 = acc[ai][bj][m][1];
                        float q = (a0[0] * a0[0] + a0[1] * a0[1]) + (a0[2] * a0[2] + a0[3] * a0[3]) + (a1[0] * a1[0] + a1[1] * a1[1]) + (a1[2] * a1[2] + a1[3] * a1[3]);
                        q = xrow16_sum(q);
                        if (fq == 0) XL[((rl0 + ai * 128 + m * 16) * 2 + bj) * 4 + wc] = q * rsv[ai][m] * rsv[ai][m];
                    }
            asm volatile("s_waitcnt lgkmcnt(0)" ::: "memory"); __builtin_amdgcn_s_barrier(); asm volatile("" ::: "memory");
#pragma unroll
            for (int ai = 0; ai < 2; ++ai) if (!(ai == 1 && u.half == 1))
#pragma unroll
                for (int m = 0; m < 4; ++m)
#pragma unroll
                    for (int bj = 0; bj < 2; ++bj) {
                        const f32x4 p = *(const LAS f32x4*)(XL + ((rl0 + ai * 128 + m * 16) * 2 + bj) * 4);
                        const float hr = rsq(((p[0] + p[1]) + (p[2] + p[3])) * (1.f / HD) + EPS) * rsv[ai][m];
                        float o[8];
#pragma unroll
                        for (int n = 0; n < 2; ++n)
#pragma unroll
                            for (int j = 0; j < 4; ++j) o[4 * n + j] = acc[ai][bj][m][n][j] * hr * gv[4 * n + j];
                        *(u32x4*)(dst + (size_t)(row0 + ai * 128 + m * 16) * ld + col0 + bj * 128) = pack8(o);
                    }
            asm volatile("s_waitcnt lgkmcnt(0)" ::: "memory"); __builtin_amdgcn_s_barrier(); asm volatile("" ::: "memory");
        } else {
#define EPIWIN_LOOP(EXPR) _Pragma("unroll") for (int ai = 0; ai < 2; ++ai) if (!(ai == 1 && u.half == 1)) _Pragma("unroll") for (int m = 0; m < 4; ++m) _Pragma("unroll") for (int bj = 0; bj < 2; ++bj) { \
                float o[8]; _Pragma("unroll") for (int n = 0; n < 2; ++n) _Pragma("unroll") for (int j = 0; j < 4; ++j) { const float v = acc[ai][bj][m][n][j] * rsv[ai][m]; o[4 * n + j] = (EXPR); } \
                *(u32x4*)(dst + (size_t)(row0 + ai * 128 + m * 16) * ld + col0 + bj * 128) = pack8(o); }
            if (mode == 0) { EPIWIN_LOOP(v) }
            else { const bool ge = (mode == 1);
                   const float c1 = ge ? 1.5957691216057308f : 1.f, c2 = ge ? 1.5957691216057308f * 0.044715f : 0.f, k0 = ge ? 0.f : 1.f, k1 = ge ? 1.f : 0.f;
                   EPIWIN_LOOP(sig1(v, c1, c2, k0, k1)) }
#undef EPIWIN_LOOP
        }
    }
};
struct EpiVT {
    EPI_NO_PREFETCH
    bf16_t* VT; const float* ss;
    __device__ __forceinline__ void operator()(EPI_ARGS) const {
        const int row0 = u.pm * 256 + wr * 64 + fr, col0 = u.pn * 256 + wc * 32 + 8 * fq;
        float rc[2][8];
#pragma unroll
        for (int bj = 0; bj < 2; ++bj)
#pragma unroll
            for (int j = 0; j < 8; ++j) rc[bj][j] = rsq(ss[col0 + bj * 128 + j] * (1.f / DM) + EPS);
#pragma unroll
        for (int ai = 0; ai < 2; ++ai) if (!(ai == 1 && u.half == 1))
#pragma unroll
            for (int m = 0; m < 4; ++m)
#pragma unroll
                for (int bj = 0; bj < 2; ++bj) {
                    float o[8];
#pragma unroll
                    for (int n = 0; n < 2; ++n)
#pragma unroll
                        for (int j = 0; j < 4; ++j) o[4 * n + j] = acc[ai][bj][m][n][j] * rc[bj][4 * n + j];
                    *(u32x4*)(VT + (size_t)(row0 + ai * 128 + m * 16) * MP + col0 + bj * 128) = pack8(o);
                }
    }
};
struct EpiGates {
    EPI_NO_PREFETCH
    unsigned* AU; const bf16_t* XC; const float *ba, *bx, *Lc;
    __device__ __forceinline__ void operator()(EPI_ARGS) const {
        const int row0 = u.pm * 256 + wr * 64 + fr, ch0 = (u.pn >> 1) * 256 + (u.pn & 1) * 128 + wc * 32 + 8 * fq;
        float va[8], vx[8], vl[8];
#pragma unroll
        for (int j = 0; j < 8; ++j) { va[j] = ba[ch0 + j]; vx[j] = bx[ch0 + j]; vl[j] = Lc[ch0 + j]; }
        u32x4 xcin[2][4];
#pragma unroll
        for (int ai = 0; ai < 2; ++ai) if (!(ai == 1 && u.half == 1))
#pragma unroll
            for (int m = 0; m < 4; ++m) xcin[ai][m] = *(const u32x4*)(XC + (size_t)(row0 + ai * 128 + m * 16) * DM + ch0);
        asm volatile("" ::: "memory");
#pragma unroll
        for (int ai = 0; ai < 2; ++ai) if (!(ai == 1 && u.half == 1))
#pragma unroll
            for (int m = 0; m < 4; ++m) {
                const int row = row0 + ai * 128 + m * 16; const size_t off = (size_t)row * DM + ch0;
                float xc[8]; unpack8(xcin[ai][m], xc);
                float a[8], uu[8];
#pragma unroll
                for (int n = 0; n < 2; ++n)
#pragma unroll
                    for (int j = 0; j < 4; ++j) { const int e = 4 * n + j;
                        const float r = sigm(acc[ai][0][m][n][j] + va[e]), ig = sigm(acc[ai][1][m][n][j] + vx[e]);
                        const float l2 = r * vl[e], av = __builtin_amdgcn_exp2f(l2); const float mult = (row == 0) ? 1.f : __builtin_amdgcn_sqrtf(fmaxf(1.f - av * av, 0.f));
                        a[e] = l2; uu[e] = mult * ig * xc[e]; }
                u32x4 w0, w1; w0.x = cvt_pk_bf16(a[0], uu[0]); w0.y = cvt_pk_bf16(a[1], uu[1]); w0.z = cvt_pk_bf16(a[2], uu[2]); w0.w = cvt_pk_bf16(a[3], uu[3]);
                w1.x = cvt_pk_bf16(a[4], uu[4]); w1.y = cvt_pk_bf16(a[5], uu[5]); w1.z = cvt_pk_bf16(a[6], uu[6]); w1.w = cvt_pk_bf16(a[7], uu[7]);
                *(u32x4*)(AU + off) = w0; *(u32x4*)(AU + off + 4) = w1;
            }
    }
};
struct EpiProj {
    EPI_NO_PREFETCH
    const bf16_t* GR; const bf16_t* GA; bf16_t* MIX; int force2;
    __device__ __forceinline__ void operator()(EPI_ARGS) const {
        const bool second = (u.half == 2) || force2; const bf16_t* G = second ? GA : GR;
        const int row0 = u.pm * 256 + wr * 64 + fr, col0 = u.pn * 256 + wc * 32 + 8 * fq;
#pragma unroll
        for (int ai = 0; ai < 2; ++ai) if (!(ai == 1 && u.half == 1)) {
            u32x4 gin[4][2], tin[4][2];
#pragma unroll
            for (int m = 0; m < 4; ++m)
#pragma unroll
                for (int bj = 0; bj < 2; ++bj) { const size_t off = (size_t)(row0 + ai * 128 + m * 16) * DM + col0 + bj * 128; gin[m][bj] = *(const u32x4*)(G + off); tin[m][bj] = second ? *(const u32x4*)(MIX + off) : (u32x4){0u, 0u, 0u, 0u}; }
            asm volatile("" ::: "memory");
#pragma unroll
            for (int m = 0; m < 4; ++m)
#pragma unroll
                for (int bj = 0; bj < 2; ++bj) {
                    const size_t off = (size_t)(row0 + ai * 128 + m * 16) * DM + col0 + bj * 128;
                    float gt[8], t[8]; unpack8(gin[m][bj], gt); unpack8(tin[m][bj], t);
                    float o[8];
#pragma unroll
                    for (int n = 0; n < 2; ++n)
#pragma unroll
                        for (int j = 0; j < 4; ++j) o[4 * n + j] = gt[4 * n + j] * acc[ai][bj][m][n][j] + t[4 * n + j];
                    *(u32x4*)(MIX + off) = pack8(o);
                }
        }
    }
};

constexpr size_t al256(size_t x) { return (x + 255) & ~(size_t)255; }
constexpr size_t SZ_WGU = (size_t)2 * FF * DM * 2, SZ_WD = (size_t)DM * FF * 2, SZ_WIN = (size_t)INC * DM * 2, SZ_WG = (size_t)32 * 256 * 256 * 2, SZ_WP = (size_t)DM * DM * 2;
constexpr size_t SZ_A16 = (size_t)MP * DM * 2, SZ_A32 = (size_t)MP * DM * 4, SZ_H = (size_t)MP * FF * 2, SZ_KV = (size_t)MP * KVW * 2;
constexpr size_t WS_CTL = 0, CTL_ZERO_BYTES = 1u << 20;
constexpr int NCH = 64, CHR = TP / NCH;
constexpr size_t WS_AGG = 1u << 20;
constexpr size_t WS_LC = WS_AGG + (size_t)2 * NCH * DM * 4;
constexpr size_t WS_WGU1 = al256(WS_LC + DM * 4);
constexpr size_t WS_WD1 = WS_WGU1 + SZ_WGU, WS_WIN = WS_WD1 + SZ_WD, WS_WG = WS_WIN + SZ_WIN, WS_WL = WS_WG + SZ_WG, WS_WA = WS_WL + SZ_WP, WS_WO = WS_WA + SZ_WP;
constexpr size_t WS_WGU2 = WS_WO + SZ_WP, WS_WD2 = WS_WGU2 + SZ_WGU;
constexpr size_t WS_XB = WS_WD2 + SZ_WD;
constexpr size_t WS_R = WS_XB + SZ_A16;
constexpr size_t WS_XR = WS_R, WS_YG = WS_XR + SZ_A16, WS_Q = WS_YG + SZ_A16, WS_GR = WS_Q + SZ_A16, WS_GA = WS_GR + SZ_A16, WS_KB = WS_GA + SZ_A16, WS_VT = WS_KB + SZ_KV;
constexpr size_t WS_H = WS_R;
constexpr size_t WS_XC = WS_VT + SZ_KV;
constexpr size_t WS_VD = WS_XC + SZ_A16;
constexpr size_t WS_END = WS_VD + (size_t)NBD * KVW * 2;
constexpr size_t WS_AO = WS_WGU1;
static_assert(WS_AO + SZ_A32 <= WS_WG, "a/u overlay must stay inside the dead weight region");
static_assert(SZ_H <= WS_XC - WS_R, "H overlay");
constexpr int CW_BAR = 4096;
constexpr size_t CTL_SS = 65536;
static_assert(CTL_SS + 3 * MP * 4 <= CTL_ZERO_BYTES, "ctl");
constexpr size_t O_Y = 0, O_PCONV = (size_t)MV * DM, O_PH = O_PCONV + 3 * DM, O_PK = O_PH + DM, O_PV = O_PK + 128 * KVW, O_SCONV = O_PV + 128 * KVW, O_SH = O_SCONV + (size_t)NBD * 3 * DM,
                 O_SK = O_SH + (size_t)NBD * DM, O_SV = O_SK + (size_t)NBD * 128 * KVW, O_END = O_SV + (size_t)NBD * 128 * KVW;

constexpr int XL_OFF = 131072, MISC_OFF = XL_OFF + 8192, LDS_BYTES = 147456;
constexpr int AT_KS = 272, AT_VS = 520, AT_VO = 256 * AT_KS;
static_assert(AT_VO + 128 * AT_VS <= MISC_OFF, "attention LDS image");

#define XB_TMO      128
#define XB_XCNT(j)  (256  + 64 * (j))
#define XB_XSUB(j)  (1280 + 64 * (j))
#define XB_XGEN(j)  (2304 + 64 * (j))
#define XB_TOP      3328
#define XB_TOPGEN   3392
#define XCD_BAR_WORDS 3456
#define XB_SPIN_CAP (1u << 22)
__device__ __forceinline__ unsigned xb_ld(unsigned* p)              { return __hip_atomic_load(p, __ATOMIC_RELAXED, __HIP_MEMORY_SCOPE_AGENT); }
__device__ __forceinline__ unsigned xb_add(unsigned* p, unsigned v) { return __hip_atomic_fetch_add(p, v, __ATOMIC_RELAXED, __HIP_MEMORY_SCOPE_AGENT); }
__device__ __forceinline__ unsigned xb_xcc_id() { return (unsigned)__builtin_amdgcn_s_getreg((3 << 11) | 20) & 0xFu; }
#define XB_SPIN(cond, bar) do { unsigned _sp = 0; while (cond) { __builtin_amdgcn_s_sleep(1); \
    if ((++_sp & 255u) == 0u) { if (xb_ld(&(bar)[XB_TMO])) break; if (_sp > XB_SPIN_CAP) { atomicAdd(&(bar)[XB_TMO], 1u); break; } } } } while (0)
struct XcdBarrier { unsigned* bar; unsigned x; volatile LAS unsigned* st; };
__device__ __forceinline__ XcdBarrier xcd_barrier_post(unsigned* bar, volatile LAS unsigned* st) {
    XcdBarrier b; b.bar = bar; b.x = xb_xcc_id(); b.st = st;
    if (threadIdx.x == 0) (void)xb_add(&bar[XB_XCNT(b.x)], 1u);
    return b;
}
__device__ __forceinline__ void xcd_barrier_complete(unsigned* bar, unsigned x, unsigned& nloc, unsigned& nx) {
    const unsigned G = gridDim.x * gridDim.y * gridDim.z;
    unsigned sum, cnt, mine, sp = 0u;
    for (;;) {
        sum = 0u; cnt = 0u; mine = 0u;
#pragma unroll
        for (unsigned j = 0; j < 16; ++j) { const unsigned c = xb_ld(&bar[XB_XCNT(j)]); sum += c; cnt += (c > 0u) ? 1u : 0u; mine = (j == x) ? c : mine; }
        if (sum == G) break;
        __builtin_amdgcn_s_sleep(1);
        if ((++sp & 255u) == 0u) { if (xb_ld(&bar[XB_TMO])) break; if (sp > XB_SPIN_CAP) { atomicAdd(&bar[XB_TMO], 1u); break; } }
    }
    nloc = mine > 0u ? mine : 1u; nx = cnt > 0u ? cnt : 1u;
}
__device__ __forceinline__ void xcd_barrier(const XcdBarrier& b) {
    asm volatile("s_waitcnt vmcnt(0)" ::: "memory");
    __syncthreads();
    if (threadIdx.x == 0) {
        unsigned* bar = b.bar;
        __builtin_amdgcn_s_waitcnt(0);
        unsigned nloc = b.st[0], nx = b.st[1];
        if (nloc == 0u) { xcd_barrier_complete(bar, b.x, nloc, nx); b.st[0] = nloc; b.st[1] = nx; }
        const unsigned old = xb_add(&bar[XB_XSUB(b.x)], 1u);
        const unsigned gen = old / nloc;
        if (old + 1u == (gen + 1u) * nloc) {
            __builtin_amdgcn_fence(__ATOMIC_RELEASE, "agent");
            asm volatile("s_waitcnt vmcnt(0)" ::: "memory");
            const unsigned og = xb_add(&bar[XB_TOP], 1u);
            const unsigned tg = og / nx;
            if (og + 1u == (tg + 1u) * nx) xb_add(&bar[XB_TOPGEN], 1u);
            else XB_SPIN(xb_ld(&bar[XB_TOPGEN]) == tg, bar);
            __builtin_amdgcn_fence(__ATOMIC_ACQUIRE, "agent");
            xb_add(&bar[XB_XGEN(b.x)], 1u);
            asm volatile("s_waitcnt vmcnt(0)" ::: "memory");
        } else {
            XB_SPIN(xb_ld(&bar[XB_XGEN(b.x)]) == gen, bar);
            __builtin_amdgcn_fence(__ATOMIC_ACQUIRE, "agent");
            asm volatile("s_waitcnt vmcnt(0)" ::: "memory");
        }
    }
    __syncthreads();
}

struct Args { const float* in[29]; float* out; unsigned char* ws; int ph_lo, ph_hi; };
static_assert(sizeof(Args) == 29 * 8 + 8 + 8 + 8, "Args has no padding");
enum { I_XP = 0, I_XS, I_SCONV, I_SH, I_CK, I_CV, I_NF1, I_WG1, I_WU1, I_WD1, I_NMIX, I_WIN, I_CW, I_CB, I_RWA, I_RBA, I_RWX, I_RBX, I_LAM, I_QN, I_KN, I_SINK, I_WL, I_WA, I_WO, I_NF2, I_WG2, I_WU2, I_WD2 };

__device__ __forceinline__ float wave_sum(float v) {
#pragma unroll
    for (int o = 1; o < 64; o <<= 1) v += __shfl_xor(v, o);
    return v;
}
#define LDS_WAIT() asm volatile("s_waitcnt lgkmcnt(0)" ::: "memory")

struct TrItem { const float* src; bf16_t* dst; const float* gain; int N, ldk; };
__device__ __forceinline__ void tr_load(const TrItem& t, float (&v)[32], int lane) {
    const float* p = t.src + (size_t)(lane >> 5) * t.N + (lane & 31);
#pragma unroll
    for (int i = 0; i < 32; ++i) v[i] = p[(size_t)(2 * i) * t.N];
}
__device__ __forceinline__ void tr_store(const TrItem& t, const float (&v)[32], LAS float* scr, int lane) {
#pragma unroll
    for (int i = 0; i < 32; ++i) scr[(2 * i + (lane >> 5)) * 33 + (lane & 31)] = v[i];
    const int c = lane & 7;
    float gv[8];
#pragma unroll
    for (int i = 0; i < 8; ++i) gv[i] = t.gain ? t.gain[8 * c + i] : 1.f;
    LDS_WAIT(); asm volatile("" ::: "memory");
#pragma unroll
    for (int j = 0; j < 4; ++j) { const int n = (lane >> 3) + 8 * j; const LAS float* s = scr + (8 * c) * 33 + n;
        u32x4 o; o.x = cvt_pk_bf16(s[0 * 33] * gv[0], s[1 * 33] * gv[1]); o.y = cvt_pk_bf16(s[2 * 33] * gv[2], s[3 * 33] * gv[3]);
        o.z = cvt_pk_bf16(s[4 * 33] * gv[4], s[5 * 33] * gv[5]); o.w = cvt_pk_bf16(s[6 * 33] * gv[6], s[7 * 33] * gv[7]);
        *(u32x4*)(t.dst + (size_t)n * t.ldk + 8 * c) = o; }
}

constexpr int I_FF = (DM / 64) * (FF / 32);
constexpr int I_IN = (DM / 64) * (INC / 32), I_PJ = (DM / 64) * (DM / 32), I_RG = 16 * 4 * 8;
constexpr int NITEMS = 6 * I_FF + I_IN + 3 * I_PJ + 2 * I_RG;
#define TR_DECODE(t, it_) do { int r = (it_); \
    if (r < 4 * I_FF) { const int which = r / I_FF; r -= which * I_FF; const int kb = r / (FF / 32), nb = r % (FF / 32), n0 = 32 * nb, k0 = 64 * kb; \
        t.src = args.in[which == 0 ? I_WG1 : which == 1 ? I_WU1 : which == 2 ? I_WG2 : I_WU2] + (size_t)k0 * FF + n0; t.N = FF; \
        t.dst = (bf16_t*)(ws + (which < 2 ? WS_WGU1 : WS_WGU2)) + (size_t)(256 * (n0 >> 7) + (n0 & 127) + 128 * (which & 1)) * DM + k0; t.ldk = DM; t.gain = args.in[which < 2 ? I_NF1 : I_NF2] + k0; break; } \
    r -= 4 * I_FF; \
    if (r < 2 * I_FF) { const int which = r / I_FF; r -= which * I_FF; const int kb = r / (DM / 32), nb = r % (DM / 32), n0 = 32 * nb, k0 = 64 * kb; \
        t.src = args.in[which ? I_WD2 : I_WD1] + (size_t)k0 * DM + n0; t.N = DM; t.dst = (bf16_t*)(ws + (which ? WS_WD2 : WS_WD1)) + ((size_t)(k0 >> 6) * DM + n0) * 64; t.ldk = 64; t.gain = nullptr; break; }     \
    r -= 2 * I_FF; \
    if (r < I_IN) { const int kb = r / (INC / 32), nb = r % (INC / 32), n0 = 32 * nb, k0 = 64 * kb; \
        t.src = args.in[I_WIN] + (size_t)k0 * INC + n0; t.N = INC; t.dst = (bf16_t*)(ws + WS_WIN) + (size_t)n0 * DM + k0; t.ldk = DM; t.gain = args.in[I_NMIX] + k0; break; } \
    r -= I_IN; \
    if (r < 3 * I_PJ) { const int which = r / I_PJ; r -= which * I_PJ; const int kb = r / (DM / 32), nb = r % (DM / 32), n0 = 32 * nb, k0 = 64 * kb; \
        t.src = args.in[which == 0 ? I_WL : which == 1 ? I_WA : I_WO] + (size_t)k0 * DM + n0; t.N = DM; t.dst = (bf16_t*)(ws + (which == 0 ? WS_WL : which == 1 ? WS_WA : WS_WO)) + (size_t)n0 * DM + k0; t.ldk = DM; t.gain = nullptr; break; } \
    r -= 3 * I_PJ; \
    { const int which = r / I_RG; r -= which * I_RG; const int blk = r / 32, kb = (r % 32) / 8, nb = r % 8, n0 = 32 * nb, k0 = 64 * kb; \
        t.src = args.in[which ? I_RWX : I_RWA] + (size_t)blk * 65536 + (size_t)k0 * 256 + n0; t.N = 256; \
        t.dst = (bf16_t*)(ws + WS_WG) + (size_t)((blk * 2 + (n0 >> 7)) * 256 + (n0 & 127) + 128 * which) * 256 + k0; t.ldk = 256; t.gain = nullptr; } \
    } while (0)

constexpr int R_WGU1 = 0, R_WGU2 = 2 * I_FF, R_WD1 = 4 * I_FF, R_WD2 = 5 * I_FF, R_WIN = 6 * I_FF, R_PJ = R_WIN + I_IN, R_RG = R_PJ + 3 * I_PJ, R_END = R_RG + 2 * I_RG;
static_assert(R_END == NITEMS, "item ranges");
constexpr int CVG1 = 237, CVG3 = 242;
constexpr int CV3_WGU2 = 20480;
constexpr int CV0_WIN = 10240;
__device__ __forceinline__ void convert_items(const Args& args, unsigned char* ws, LAS unsigned char* lds, int lo, int hi, int rank, int nranks, int wave, int lane) {
    LAS float* scr0 = (LAS float*)(lds + wave * 16896); LAS float* scr1 = scr0 + 64 * 33;
    float v0[32], v1[32], v2[32], v3[32]; TrItem t0, t1, t2, t3;
    int it = lo + rank;
#define CV_LOAD(t, v, idx) do { const int i_ = (idx); if (i_ < hi) { TR_DECODE(t, i_); tr_load(t, v, lane); } } while (0)
    CV_LOAD(t0, v0, it); CV_LOAD(t1, v1, it + nranks); CV_LOAD(t2, v2, it + 2 * nranks); CV_LOAD(t3, v3, it + 3 * nranks);
    while (it < hi) {
        tr_store(t0, v0, scr0, lane); CV_LOAD(t0, v0, it + 4 * nranks);
        if (it + nranks >= hi) break;
        tr_store(t1, v1, scr1, lane); CV_LOAD(t1, v1, it + 5 * nranks);
        if (it + 2 * nranks >= hi) break;
        tr_store(t2, v2, scr0, lane); CV_LOAD(t2, v2, it + 6 * nranks);
        if (it + 3 * nranks >= hi) break;
        tr_store(t3, v3, scr1, lane); CV_LOAD(t3, v3, it + 7 * nranks);
        it += 4 * nranks;
    }
#undef CV_LOAD
    LDS_WAIT();
}

__device__ __forceinline__ void skinny_acc(const bf16_t* X, int lda, const bf16_t* Wt, int ldb, int kbeg, int ksteps, f32x4 (&acc)[4][2], int lane) {
    const int j = lane & 15, q = lane >> 4;
    const bf16_t* wp = Wt + (size_t)j * ldb + kbeg + 8 * q;
    const bf16_t* xp = X + (size_t)j * lda + kbeg + 8 * q;
    asm volatile("" : "+s"(ksteps));
#pragma unroll 4
    for (int s = 0; s < ksteps; ++s) {
        bf16x8 wf[2], xf[4];
#pragma unroll
        for (int nt = 0; nt < 2; ++nt) wf[nt] = *(const bf16x8*)(wp + (size_t)(16 * nt) * ldb + 32 * s);
#pragma unroll
        for (int mt = 0; mt < 4; ++mt) xf[mt] = *(const bf16x8*)(xp + (size_t)(16 * mt) * lda + 32 * s);
#pragma unroll
        for (int mt = 0; mt < 4; ++mt)
#pragma unroll
            for (int nt = 0; nt < 2; ++nt) acc[mt][nt] = __builtin_amdgcn_mfma_f32_16x16x32_bf16(wf[nt], xf[mt], acc[mt][nt], 0, 0, 0);
    }
}
__device__ __forceinline__ void skinny_acc_tm(const bf16_t* X, size_t tsX, const bf16_t* Wt, size_t tsW, int kbeg, int ksteps, f32x4 (&acc)[4][2], int lane) {
    const int j = lane & 15, q = lane >> 4;
    const bf16_t* wp = Wt + (size_t)j * 64 + 8 * q;
    const bf16_t* xp = X + (size_t)j * 64 + 8 * q;
    int g0 = kbeg >> 5;
    asm volatile("" : "+s"(ksteps));
#pragma unroll 4
    for (int s = 0; s < ksteps; ++s) {
        const int gi = g0 + s; const size_t tw = (size_t)(gi >> 1) * tsW + (gi & 1) * 32, tx = (size_t)(gi >> 1) * tsX + (gi & 1) * 32;
        bf16x8 wf[2], xf[4];
#pragma unroll
        for (int nt = 0; nt < 2; ++nt) wf[nt] = *(const bf16x8*)(wp + tw + (size_t)(16 * nt) * 64);
#pragma unroll
        for (int mt = 0; mt < 4; ++mt) xf[mt] = *(const bf16x8*)(xp + tx + (size_t)(16 * mt) * 64);
#pragma unroll
        for (int mt = 0; mt < 4; ++mt)
#pragma unroll
            for (int nt = 0; nt < 2; ++nt) acc[mt][nt] = __builtin_amdgcn_mfma_f32_16x16x32_bf16(wf[nt], xf[mt], acc[mt][nt], 0, 0, 0);
    }
}
__device__ __forceinline__ void skinny_zero(f32x4 (&acc)[4][2]) {
#pragma unroll
    for (int mt = 0; mt < 4; ++mt)
#pragma unroll
        for (int nt = 0; nt < 2; ++nt) acc[mt][nt] = (f32x4){0.f, 0.f, 0.f, 0.f};
}
__device__ __forceinline__ void skinny_store(LAS float* part, const f32x4 (&acc)[4][2], int wave, int lane) {
    const int j = lane & 15, q = lane >> 4;
#pragma unroll
    for (int mt = 0; mt < 4; ++mt)
#pragma unroll
        for (int nt = 0; nt < 2; ++nt) *(LAS f32x4*)(part + ((wave * 64 + 16 * mt + j) * 32 + 16 * nt + 4 * q)) = acc[mt][nt];
}
__device__ __forceinline__ f32x4 skinny_sum(const LAS float* part, int rowl, int c4) {
    f32x4 sum = (f32x4){0.f, 0.f, 0.f, 0.f};
#pragma unroll
    for (int w = 0; w < 8; ++w) sum += *(const LAS f32x4*)(part + ((w * 64 + rowl) * 32 + 4 * c4));
    return sum;
}
template <int MODE, bool TM> __device__ __forceinline__ void skinny_resid(LAS unsigned char* lds, const bf16_t* Xa, int lda, const bf16_t* Wt, int K, const float* Xin, bf16_t* XB, float* ssn, float* out, float sc, int G, int bx, int tid, int wave, int lane) {
    LAS float* part = (LAS float*)lds;
    for (int unit = bx; unit < 2 * (DM / 32); unit += G) {
        const int r0 = 64 * (unit & 1), n0 = 32 * (unit >> 1);
        f32x4 acc[4][2]; skinny_zero(acc);
        if (TM) skinny_acc_tm(Xa + (size_t)r0 * 64, (size_t)MP * 64, Wt + (size_t)n0 * 64, (size_t)DM * 64, wave * (K / 8), K / 256, acc, lane);
        else skinny_acc(Xa + (size_t)r0 * lda, lda, Wt + (size_t)n0 * K, K, wave * (K / 8), K / 256, acc, lane);
        skinny_store(part, acc, wave, lane);
        __syncthreads();
        const int rowl = tid >> 3, c4 = tid & 7; const size_t off = (size_t)(TP + r0 + rowl) * DM + n0 + 4 * c4;
        f32x4 xin;
        if (MODE == 0) xin = *(const f32x4*)(Xin + off); else { const u32x2 xb = *(const u32x2*)(XB + off); xin = (f32x4){bf_lo(xb.x), bf_hi(xb.x), bf_lo(xb.y), bf_hi(xb.y)}; }
        const f32x4 v = xin + skinny_sum(part, rowl, c4) * sc;
        if (MODE == 2) *(f32x4*)(out + off) = v;
        else {
            u32x2 w; w.x = cvt_pk_bf16(v[0], v[1]); w.y = cvt_pk_bf16(v[2], v[3]); *(u32x2*)(XB + off) = w;
            float q = (v[0] * v[0] + v[1] * v[1]) + (v[2] * v[2] + v[3] * v[3]); q += __shfl_xor(q, 1); q += __shfl_xor(q, 2); q += __shfl_xor(q, 4);
            if (c4 == 0) __hip_atomic_fetch_add(ssn + TP + r0 + rowl, q, __ATOMIC_RELAXED, __HIP_MEMORY_SCOPE_AGENT);
        }
        __syncthreads();
    }
}

__global__ void __launch_bounds__(512, 2) mk_fwd(Args args) {
    extern __shared__ __attribute__((aligned(16))) unsigned char lds_raw[];
    LAS unsigned char* lds = (LAS unsigned char*)lds_raw;
    volatile LAS unsigned* MISC = (volatile LAS unsigned*)(lds + MISC_OFF);
    const int tid = threadIdx.x, lane = tid & 63, wave = __builtin_amdgcn_readfirstlane(tid >> 6);
    const int G = gridDim.x, bx = blockIdx.x;
    const int vcu = (G % 8 == 0) ? (bx % 8) * (G / 8) + bx / 8 : bx;
    unsigned char* ws = args.ws;
    unsigned* ctl = (unsigned*)(ws + WS_CTL);
    float* SS0 = (float*)(ws + WS_CTL + CTL_SS); float* SS1 = SS0 + MP; float* SS2 = SS1 + MP;
    float* CP = (float*)(ws + WS_AGG); float* CH = CP + NCH * DM; float* LC = (float*)(ws + WS_LC);
    bf16_t* WGU1 = (bf16_t*)(ws + WS_WGU1); bf16_t* WD1 = (bf16_t*)(ws + WS_WD1); bf16_t* WIN = (bf16_t*)(ws + WS_WIN); bf16_t* WGT = (bf16_t*)(ws + WS_WG);
    bf16_t* WL = (bf16_t*)(ws + WS_WL); bf16_t* WA = (bf16_t*)(ws + WS_WA); bf16_t* WO = (bf16_t*)(ws + WS_WO); bf16_t* WGU2 = (bf16_t*)(ws + WS_WGU2); bf16_t* WD2 = (bf16_t*)(ws + WS_WD2);
    bf16_t* XB = (bf16_t*)(ws + WS_XB);
    bf16_t* XR = (bf16_t*)(ws + WS_XR); bf16_t* YG = (bf16_t*)(ws + WS_YG); bf16_t* QB = (bf16_t*)(ws + WS_Q); bf16_t* GR = (bf16_t*)(ws + WS_GR); bf16_t* GA = (bf16_t*)(ws + WS_GA);
    bf16_t* KB = (bf16_t*)(ws + WS_KB); bf16_t* VT = (bf16_t*)(ws + WS_VT); bf16_t* HB = (bf16_t*)(ws + WS_H); bf16_t* XC = (bf16_t*)(ws + WS_XC); bf16_t* MIX = XC; bf16_t* VD = (bf16_t*)(ws + WS_VD);
    unsigned* AU = (unsigned*)(ws + WS_AO);
    float* out = args.out;

    for (int i = tid; i < (LDS_BYTES - MISC_OFF) / 4; i += 512) ((LAS unsigned*)(lds + MISC_OFF))[i] = 0u;
    __syncthreads();
    XcdBarrier bar; bar.bar = ctl + CW_BAR; bar.x = 0; bar.st = nullptr;
    if (!MK_PER_PHASE) bar = xcd_barrier_post(ctl + CW_BAR, MISC + 8);
    const int lo = args.ph_lo, hi = args.ph_hi;
    const bool cvsplit = (G == 256);
#define IN(k) (lo <= (k) && (k) < hi)
#define SEAM(k) do { if (IN(k) && IN((k) + 1)) xcd_barrier(bar); } while (0)

    if (IN(0)) {
        const int gw = vcu * 8 + wave, NGW = G * 8;
        if (!cvsplit) convert_items(args, ws, lds, 0, NITEMS, gw, NGW, wave, lane);
        else {
            convert_items(args, ws, lds, R_WGU1, R_WGU2, gw, NGW, wave, lane);
            convert_items(args, ws, lds, R_WGU2 + CV3_WGU2, R_WD1, gw, NGW, wave, lane);
            convert_items(args, ws, lds, R_WIN, R_WIN + CV0_WIN, gw, NGW, wave, lane);
        }
        for (int m = gw; m < MP; m += NGW) {
            const float* src = m < TP ? args.in[I_XP] + (size_t)m * DM : (m < MV ? args.in[I_XS] + (size_t)(m - TP) * DM : nullptr);
            float s = 0.f;
#pragma unroll
            for (int j = 0; j < 16; ++j) {
                const int c = 4 * lane + 256 * j; f32x4 v = src ? *(const f32x4*)(src + c) : (f32x4){0.f, 0.f, 0.f, 0.f};
                u32x2 w; w.x = cvt_pk_bf16(v[0], v[1]); w.y = cvt_pk_bf16(v[2], v[3]); *(u32x2*)(XB + (size_t)m * DM + c) = w;
                s += (v[0] * v[0] + v[1] * v[1]) + (v[2] * v[2] + v[3] * v[3]); }
            s = wave_sum(s); if (lane == 0) SS0[m] = s;
        }
        for (int c = bx * 512 + tid; c < DM; c += G * 512) { const float l = args.in[I_LAM][c]; LC[c] = 8.f * 1.4426950408889634f * (fminf(l, 0.f) - log1pf(__expf(-fabsf(l)))); }
    }
    SEAM(0);

    if (IN(1)) {
        if (cvsplit && bx >= CVG1) {
            const int rk = (bx - CVG1) * 8 + wave, nr = (G - CVG1) * 8;
            convert_items(args, ws, lds, R_WD1, R_WD2, rk, nr, wave, lane);
            convert_items(args, ws, lds, R_WIN + CV0_WIN, R_PJ, rk, nr, wave, lane);
        } else {
        pg8::Gemm g{XB, WGU1, DM, DM, DM, 128, 128, 0, 0}; pg8::Order<0> S; S.init(32, 2 * FF / 256, 2 * FF / 256, cvsplit ? CVG1 : G, bx);
        EpiSwiglu E{HB, SS0};
        pg8::gemm_phase(lds, g, S, E);
        }
    }
    SEAM(1);
    if (IN(2)) {
        pg8::Gemm g{HB, WD1, 64, 64, FF, (size_t)MP * 128, (size_t)DM * 128, 0, 0};   pg8::Order<0> S; S.init(32, DM / 256, 0, G, bx);
        EpiResid<1> E{nullptr, XB, nullptr, SS1, 0.5f};
        pg8::gemm_phase(lds, g, S, E);
        skinny_resid<1, true>(lds, HB + (size_t)TP * 64, 64, WD1, FF, nullptr, XB, SS1, nullptr, 0.5f, G, bx, tid, wave, lane);
    }
    SEAM(2);
    if (IN(3)) {
        if (cvsplit && bx >= CVG3) {
            const int rk = (bx - CVG3) * 8 + wave, nr = (G - CVG3) * 8;
            convert_items(args, ws, lds, R_PJ, R_END, rk, nr, wave, lane);
            convert_items(args, ws, lds, R_WGU2, R_WGU2 + CV3_WGU2, rk, nr, wave, lane);
        } else {
        const int GG = cvsplit ? CVG3 : G;
        { pg8::Gemm g{XB, WIN, DM, DM, DM, 128, 128, 0, 0}; pg8::Order<2> S; S.init(32, INC / 256 - 4, INC / 256, GG, bx);
          EpiWin E{XR, YG, QB, KB, VD, GR, GA, SS1, args.in[I_QN], args.in[I_KN]};
          pg8::gemm_phase(lds, g, S, E); }
        const int remM = (32 * (INC / 256 - 4)) % GG, sV = bx - remM - INC / 256;
        const int nV = cvsplit ? 128 : G, cV = cvsplit ? sV : (bx + G / 2) % G;
        if (cV >= 0 && cV < nV) { pg8::Gemm g{WIN + (size_t)(2 * DM + DM + KVW) * DM, XB, DM, DM, DM, 128, 128, 0, 0}; pg8::Order<0> S; S.init(KVW / 256, 32, 0, nV, cV);
          EpiVT E{VT, SS1};
          pg8::gemm_phase(lds, g, S, E); }
        }
    }
    SEAM(3);
    if (IN(4)) {
        const float* cw = args.in[I_CW]; const float* cbias = args.in[I_CB];
        const bool spec = (G == 256); const int cth = spec ? tid - 256 : tid, cnt = spec ? 256 : 512;
        if (!spec || wave >= 4) {
        for (int s = bx * cnt + cth; s < 256 * 512; s += G * cnt) {
            const int rc = s >> 9, c0 = (s & 511) * 8, r0 = rc * 32;
            float w0[8], w1[8], w2[8], w3[8], cb[8];
#pragma unroll
            for (int j = 0; j < 8; ++j) { w0[j] = cw[c0 + j]; w1[j] = cw[DM + c0 + j]; w2[j] = cw[2 * DM + c0 + j]; w3[j] = cw[3 * DM + c0 + j]; cb[j] = cbias[c0 + j]; }
            float xm3[8], xm2[8], xm1[8];
            if (r0 == 0) {
#pragma unroll
                for (int j = 0; j < 8; ++j) { xm3[j] = 0.f; xm2[j] = 0.f; xm1[j] = 0.f; }
            } else { unpack8(*(const u32x4*)(XR + (size_t)(r0 - 3) * DM + c0), xm3); unpack8(*(const u32x4*)(XR + (size_t)(r0 - 2) * DM + c0), xm2); unpack8(*(const u32x4*)(XR + (size_t)(r0 - 1) * DM + c0), xm1); }
            for (int rb = r0; rb < r0 + 32; rb += 16) {
                u32x4 xin[16];
#pragma unroll
                for (int q = 0; q < 16; ++q) xin[q] = *(const u32x4*)(XR + (size_t)(rb + q) * DM + c0);
#pragma unroll
                for (int q = 0; q < 16; ++q) {
                    float x[8], o[8]; unpack8(xin[q], x);
#pragma unroll
                    for (int j = 0; j < 8; ++j) { o[j] = cb[j] + w0[j] * xm3[j] + w1[j] * xm2[j] + w2[j] * xm1[j] + w3[j] * x[j]; xm3[j] = xm2[j]; xm2[j] = xm1[j]; xm1[j] = x[j]; }
                    *(u32x4*)(XC + (size_t)(rb + q) * DM + c0) = pack8(o);
                }
            }
            if (r0 == TP - 32) {
#pragma unroll
                for (int j = 0; j < 8; ++j) { out[O_PCONV + c0 + j] = xm3[j]; out[O_PCONV + DM + c0 + j] = xm2[j]; out[O_PCONV + 2 * DM + c0 + j] = xm1[j]; }
            }
        }
        for (int s = bx * cnt + cth; s < NBD * 512; s += G * cnt) {
            const int b = s >> 9, c0 = (s & 511) * 8, rr = TP + b;
            const float* p = args.in[I_SCONV] + (size_t)b * 3 * DM + c0; float* so = out + O_SCONV + (size_t)b * 3 * DM + c0;
            const f32x4 p0a = *(const f32x4*)p, p0b = *(const f32x4*)(p + 4), p1a = *(const f32x4*)(p + DM), p1b = *(const f32x4*)(p + DM + 4), p2a = *(const f32x4*)(p + 2 * DM), p2b = *(const f32x4*)(p + 2 * DM + 4);
            float x[8], o[8]; unpack8(*(const u32x4*)(XR + (size_t)rr * DM + c0), x);
            const f32x4 w0a = *(const f32x4*)(cw + c0), w0b = *(const f32x4*)(cw + c0 + 4), w1a = *(const f32x4*)(cw + DM + c0), w1b = *(const f32x4*)(cw + DM + c0 + 4);
            const f32x4 w2a = *(const f32x4*)(cw + 2 * DM + c0), w2b = *(const f32x4*)(cw + 2 * DM + c0 + 4), w3a = *(const f32x4*)(cw + 3 * DM + c0), w3b = *(const f32x4*)(cw + 3 * DM + c0 + 4);
            const f32x4 cba = *(const f32x4*)(cbias + c0), cbb = *(const f32x4*)(cbias + c0 + 4);
#pragma unroll
            for (int j = 0; j < 4; ++j) { o[j] = cba[j] + w0a[j] * p0a[j] + w1a[j] * p1a[j] + w2a[j] * p2a[j] + w3a[j] * x[j]; o[4 + j] = cbb[j] + w0b[j] * p0b[j] + w1b[j] * p1b[j] + w2b[j] * p2b[j] + w3b[j] * x[4 + j]; }
            *(f32x4*)so = p1a; *(f32x4*)(so + 4) = p1b; *(f32x4*)(so + DM) = p2a; *(f32x4*)(so + DM + 4) = p2b;
            *(f32x4*)(so + 2 * DM) = (f32x4){x[0], x[1], x[2], x[3]}; *(f32x4*)(so + 2 * DM + 4) = (f32x4){x[4], x[5], x[6], x[7]};
            *(u32x4*)(XC + (size_t)rr * DM + c0) = pack8(o);
        }
        for (int e = bx * cnt + cth; e < 128 * KVW; e += G * cnt) {
            const int tok = e >> 10, gd = e & 1023;
            out[O_PK + e] = bf2f(KB[(size_t)(TP - 128 + tok) * KVW + gd]);
            out[O_PV + e] = bf2f(VT[(size_t)gd * MP + TP - 128 + tok]);
        }
        }
        {
            const float* ck = args.in[I_CK]; const float* cv = args.in[I_CV];
            const float scale = 0.08838834764831845f;
            const int r = lane >> 4;
            for (int p = wave * G + vcu; p < NBD * NKV; p += G * 8) {
                int i8 = (lane & 15) * 8; asm volatile("" : "+v"(i8));
                const int b = p >> 3, g = p & 7; const size_t row = (size_t)(TP + b);
                float q[4][8], o[4][8], m[4], l[4], slope[4];
#pragma unroll
                for (int hh = 0; hh < 4; ++hh) { unpack8(*(const u32x4*)(QB + row * DM + (4 * g + hh) * 128 + i8), q[hh]);
                    const float sink = args.in[I_SINK][4 * g + hh]; m[hh] = (r == 0) ? sink : -1e30f; l[hh] = (r == 0) ? 1.f : 0.f; slope[hh] = exp2f(-8.f * (float)(4 * g + hh + 1) / 32.f);
#pragma unroll
                    for (int e = 0; e < 8; ++e) o[hh][e] = 0.f; }
                const float* kp = ck + (((size_t)b * 128) * NKV + g) * HD + i8; const float* vp = cv + (((size_t)b * 128) * NKV + g) * HD + i8;
                float* ko = out + O_SK + (((size_t)b * 128) * NKV + g) * HD + i8; float* vo = out + O_SV + (((size_t)b * 128) * NKV + g) * HD + i8;
                const int kbase = r + 1;
                f32x4 pk[4][4];
#define DEC_LOAD(slot, kk_) do { const int kn_ = (kk_); \
                    if (kn_ < 128) { pk[slot][0] = *(const f32x4*)(kp + (size_t)kn_ * KVW); pk[slot][1] = *(const f32x4*)(kp + (size_t)kn_ * KVW + 4); pk[slot][2] = *(const f32x4*)(vp + (size_t)kn_ * KVW); pk[slot][3] = *(const f32x4*)(vp + (size_t)kn_ * KVW + 4); } \
                    else { float t_[8]; unpack8(*(const u32x4*)(KB + row * KVW + g * 128 + i8), t_); pk[slot][0] = (f32x4){t_[0], t_[1], t_[2], t_[3]}; pk[slot][1] = (f32x4){t_[4], t_[5], t_[6], t_[7]}; \
                           unpack8(*(const u32x4*)(VD + (size_t)b * KVW + g * 128 + i8), t_); pk[slot][2] = (f32x4){t_[0], t_[1], t_[2], t_[3]}; pk[slot][3] = (f32x4){t_[4], t_[5], t_[6], t_[7]}; } } while (0)
#define DEC_STEP(slot, it_) do { const int kk = kbase + 4 * (it_); \
                    const f32x4 k0 = pk[slot][0], k1 = pk[slot][1], v0 = pk[slot][2], v1 = pk[slot][3]; \
                    if ((it_) + 4 < 32) DEC_LOAD(slot, kk + 16); \
                    if (kk == 128 || !cvsplit) {       \
                        *(f32x4*)(ko + (size_t)(kk - 1) * KVW) = k0; *(f32x4*)(ko + (size_t)(kk - 1) * KVW + 4) = k1; *(f32x4*)(vo + (size_t)(kk - 1) * KVW) = v0; *(f32x4*)(vo + (size_t)(kk - 1) * KVW + 4) = v1; } \
                    const float kf[8] = {k0[0], k0[1], k0[2], k0[3], k1[0], k1[1], k1[2], k1[3]}, vf[8] = {v0[0], v0[1], v0[2], v0[3], v1[0], v1[1], v1[2], v1[3]}; \
                    const float dist = (float)(128 - kk); \
                    _Pragma("unroll") for (int hh = 0; hh < 4; ++hh) { float d = 0.f; \
                        _Pragma("unroll") for (int e = 0; e < 8; ++e) d += q[hh][e] * kf[e]; \
                        d = rowsum16(d); const float sv = d * scale - slope[hh] * dist; \
                        const float mn = fmaxf(m[hh], sv), al = __expf(m[hh] - mn), pp = __expf(sv - mn); l[hh] = l[hh] * al + pp; m[hh] = mn; \
                        _Pragma("unroll") for (int e = 0; e < 8; ++e) o[hh][e] = o[hh][e] * al + pp * vf[e]; } } while (0)
                DEC_LOAD(0, kbase); DEC_LOAD(1, kbase + 4); DEC_LOAD(2, kbase + 8); DEC_LOAD(3, kbase + 12);
                for (int it = 0; it < 32; it += 4) { DEC_STEP(0, it); DEC_STEP(1, it + 1); DEC_STEP(2, it + 2); DEC_STEP(3, it + 3); }
#undef DEC_LOAD
#undef DEC_STEP
#pragma unroll
                for (int hh = 0; hh < 4; ++hh) {
                    const float M = xrow16_max(m[hh]);
                    const float f = __expf(m[hh] - M); const float lt = xrow16_sum(l[hh] * f);
                    const float inv = 1.f / lt; float oo[8];
#pragma unroll
                    for (int e = 0; e < 8; ++e) oo[e] = xrow16_sum(o[hh][e] * f) * inv;
                    if (r == 0) *(u32x4*)(QB + row * DM + (4 * g + hh) * 128 + i8) = pack8(oo);
                }
            }
        }
        {
            const float scale = 0.08838834764831845f;
            const int c = lane & 31, hq = lane >> 5;
            for (int unit = bx; unit < 64 * NKV; unit += G) {
                const int n = unit >> 3, g = unit & 7, tok0 = 128 * (n - 1);
                int t2 = tid; asm volatile("" : "+v"(t2));
                {
                    const int kj0 = t2 >> 4, c16 = t2 & 15;
                    const bf16_t* gk = KB + (size_t)(tok0 + kj0) * KVW + g * 128 + c16 * 8;
                    LAS unsigned char* lk = lds + kj0 * AT_KS + c16 * 16;
#pragma unroll
                    for (int i = 0; i < 8; ++i) { u32x4 v = (u32x4){0u, 0u, 0u, 0u}; if (n > 0 || i >= 4) v = *(const u32x4*)(gk + (size_t)i * 32 * KVW);
                        *(LAS u32x4*)(lk + i * 32 * AT_KS) = v; }
                    const int d0 = t2 >> 5, cc = t2 & 31;
                    const bf16_t* gv = VT + (size_t)(g * 128 + d0) * MP + tok0 + 8 * cc;
                    LAS unsigned char* lv = lds + AT_VO + d0 * AT_VS + cc * 16;
#pragma unroll
                    for (int i = 0; i < 8; ++i) { u32x4 v = (u32x4){0u, 0u, 0u, 0u}; if (n > 0 || cc >= 16) v = *(const u32x4*)(gv + (size_t)i * 16 * MP);
                        *(LAS u32x2*)(lv + i * 16 * AT_VS) = (u32x2){v.x, v.y}; *(LAS u32x2*)(lv + i * 16 * AT_VS + 8) = (u32x2){v.z, v.w}; }
                }
                __syncthreads();
                const int hh = wave >> 1, h = 4 * g + hh; const float slope = exp2f(-8.f * (float)(h + 1) / 32.f), sink = args.in[I_SINK][h];
#define ATT_QTILE(Qf, q0) do { const int kt0 = (q0) >> 5; bf16_t* qrow = QB + (size_t)(128 * n + (q0) + c) * DM + h * 128; \
                    f32x16 S[5]; \
                    const LAS unsigned char* kbase = lds + (32 * kt0 + c) * AT_KS + hq * 16; \
                    const LAS unsigned char* vbase = lds + AT_VO + c * AT_VS + kt0 * 64 + hq * 8; \
_Pragma("unroll") \
                    for (int t = 0; t < 5; ++t) { \
_Pragma("unroll") \
                        for (int r = 0; r < 16; ++r) S[t][r] = 0.f; \
_Pragma("unroll") \
                        for (int s = 0; s < 8; ++s) { const bf16x8 Kf = *(const LAS bf16x8*)(kbase + t * 32 * AT_KS + s * 32); \
                            S[t] = __builtin_amdgcn_mfma_f32_32x32x16_bf16(Kf, Qf[s], S[t], 0, 0, 0); } \
                        __builtin_amdgcn_sched_barrier(0); \
                    } \
                      \
                    int dbase = c - 4 * hq; asm volatile("" : "+v"(dbase));     \
                    const unsigned lim = n > 0 ? 128u : (unsigned)(q0 + c + 1); \
                    float mx = sink; \
_Pragma("unroll") \
                    for (int t = 0; t < 5; ++t) \
_Pragma("unroll") \
                        for (int r = 0; r < 16; ++r) { const int dist = dbase + (128 - 32 * t - (r & 3) - 8 * (r >> 2)); \
                            const float sv = ((unsigned)dist < lim) ? S[t][r] * scale - slope * (float)dist : -INFINITY; S[t][r] = sv; mx = fmaxf(mx, sv); } \
                    mx = fmaxf(mx, __shfl_xor(mx, 32)); \
                    float ls = 0.f; \
_Pragma("unroll") \
                    for (int t = 0; t < 5; ++t) \
_Pragma("unroll") \
                        for (int r = 0; r < 16; ++r) { const float pp = __expf(S[t][r] - mx); S[t][r] = pp; ls += pp; } \
                    ls += __shfl_xor(ls, 32); ls += __expf(sink - mx); \
                    u32x4 Pk[5][2]; \
_Pragma("unroll") \
                    for (int t = 0; t < 5; ++t) \
_Pragma("unroll") \
                        for (int s2 = 0; s2 < 2; ++s2) { \
                            Pk[t][s2].x = cvt_pk_bf16(S[t][8 * s2 + 0], S[t][8 * s2 + 1]); Pk[t][s2].y = cvt_pk_bf16(S[t][8 * s2 + 2], S[t][8 * s2 + 3]); \
                            Pk[t][s2].z = cvt_pk_bf16(S[t][8 * s2 + 4], S[t][8 * s2 + 5]); Pk[t][s2].w = cvt_pk_bf16(S[t][8 * s2 + 6], S[t][8 * s2 + 7]); } \
                    __builtin_amdgcn_sched_barrier(0); \
                    f32x16 O[4]; \
_Pragma("unroll") \
                    for (int dt = 0; dt < 4; ++dt) \
_Pragma("unroll") \
                        for (int r = 0; r < 16; ++r) O[dt][r] = 0.f; \
_Pragma("unroll") \
                    for (int t = 0; t < 5; ++t) \
_Pragma("unroll") \
                        for (int s2 = 0; s2 < 2; ++s2) { \
                            union { u32x4 u; bf16x8 b; } pf; pf.u = Pk[t][s2]; \
_Pragma("unroll") \
                            for (int dt = 0; dt < 4; ++dt) { \
                                const u32x2 vlo = *(const LAS u32x2*)(vbase + dt * 32 * AT_VS + t * 64 + s2 * 32), vhi = *(const LAS u32x2*)(vbase + dt * 32 * AT_VS + t * 64 + s2 * 32 + 16); \
                                union { u32x4 u; bf16x8 b; } vf; vf.u = (u32x4){vlo.x, vlo.y, vhi.x, vhi.y}; \
                                O[dt] = __builtin_amdgcn_mfma_f32_32x32x16_bf16(vf.b, pf.b, O[dt], 0, 0, 0); } \
                            __builtin_amdgcn_sched_barrier(0); \
                        } \
                    const float inv = 1.f / ls; \
_Pragma("unroll") \
                    for (int dt = 0; dt < 4; ++dt) \
_Pragma("unroll") \
                        for (int gp = 0; gp < 2; ++gp) {         \
                            u32x2 a, b; \
                            a.x = cvt_pk_bf16(O[dt][8 * gp] * inv, O[dt][8 * gp + 1] * inv); a.y = cvt_pk_bf16(O[dt][8 * gp + 2] * inv, O[dt][8 * gp + 3] * inv); \
                            b.x = cvt_pk_bf16(O[dt][8 * gp + 4] * inv, O[dt][8 * gp + 5] * inv); b.y = cvt_pk_bf16(O[dt][8 * gp + 6] * inv, O[dt][8 * gp + 7] * inv); \
                            { auto r = __builtin_amdgcn_permlane32_swap(a.x, b.x, false, false); a.x = r[0]; b.x = r[1]; } \
                            { auto r = __builtin_amdgcn_permlane32_swap(a.y, b.y, false, false); a.y = r[0]; b.y = r[1]; } \
                            *(u32x4*)(qrow + 32 * dt + 16 * gp + 8 * hq) = (u32x4){a.x, a.y, b.x, b.y}; } \
                } while (0)
                {
                    const int qa = (wave & 1) * 64, qb = qa + 32;
                    bf16x8 QfA[8], QfB[8];
                    const bf16_t* qra = QB + (size_t)(128 * n + qa + c) * DM + h * 128 + 8 * hq; const bf16_t* qrb = qra + (size_t)32 * DM;
#pragma unroll
                    for (int s_ = 0; s_ < 8; ++s_) QfA[s_] = *(const bf16x8*)(qra + 16 * s_);
#pragma unroll
                    for (int s_ = 0; s_ < 8; ++s_) QfB[s_] = *(const bf16x8*)(qrb + 16 * s_);
                    ATT_QTILE(QfA, qa);
                    __builtin_amdgcn_sched_barrier(0);
                    ATT_QTILE(QfB, qb);
                }
#undef ATT_QTILE
                __syncthreads();
            }
        }
    }
    SEAM(4);
    if (IN(5)) {
        pg8::Gemm g{XC, WGT, DM, 256, 256, 128, 128, 0, 0}; pg8::Order<1> S; S.init(32, 32, 32, G, bx);
        EpiGates E{AU, XC, args.in[I_RBA], args.in[I_RBX], LC};
        pg8::gemm_phase(lds, g, S, E);
    }
    SEAM(5);
    if (IN(6)) {
        for (int wt = wave * G + bx; wt < NCH * 16; wt += 8 * G) {
            const int j = wt >> 4, ch4 = ((wt & 15) * 64 + lane) * 4; const size_t base = (size_t)j * CHR * DM + ch4;
            float Sl[4] = {0.f, 0.f, 0.f, 0.f}, Hh[4] = {0.f, 0.f, 0.f, 0.f};
#pragma unroll 16
            for (int t = 0; t < CHR; ++t) { const u32x4 w = *(const u32x4*)(AU + base + (size_t)t * DM);
#pragma unroll
                for (int k = 0; k < 4; ++k) { const float l2 = bf_lo(w[k]); Hh[k] = __builtin_amdgcn_exp2f(l2) * Hh[k] + bf_hi(w[k]); Sl[k] += l2; } }
            *(f32x4*)(CP + j * DM + ch4) = (f32x4){__builtin_amdgcn_exp2f(Sl[0]), __builtin_amdgcn_exp2f(Sl[1]), __builtin_amdgcn_exp2f(Sl[2]), __builtin_amdgcn_exp2f(Sl[3])};
            *(f32x4*)(CH + j * DM + ch4) = (f32x4){Hh[0], Hh[1], Hh[2], Hh[3]};
        }
    }
    SEAM(6);
    if (IN(7)) {
        for (int wt = wave * G + bx; wt < NCH * 16; wt += 8 * G) {
            const int j = wt >> 4, ch4 = ((wt & 15) * 64 + lane) * 4; const size_t base = (size_t)j * CHR * DM + ch4;
            float h[4] = {0.f, 0.f, 0.f, 0.f};
            for (int j0 = 0; j0 < j; j0 += 16) {
                f32x4 cp[16], cq[16];
#pragma unroll
                for (int e = 0; e < 16; ++e) if (j0 + e < j) { cp[e] = *(const f32x4*)(CP + (j0 + e) * DM + ch4); cq[e] = *(const f32x4*)(CH + (j0 + e) * DM + ch4); }
#pragma unroll
                for (int e = 0; e < 16; ++e) if (j0 + e < j) {
#pragma unroll
                    for (int k = 0; k < 4; ++k) h[k] = cp[e][k] * h[k] + cq[e][k]; }
            }
#pragma unroll 16
            for (int t = 0; t < CHR; ++t) { const size_t o = base + (size_t)t * DM; const u32x4 w = *(const u32x4*)(AU + o); const u32x2 y = *(const u32x2*)(YG + o);
#pragma unroll
                for (int k = 0; k < 4; ++k) h[k] = __builtin_amdgcn_exp2f(bf_lo(w[k])) * h[k] + bf_hi(w[k]);
                u32x2 r; r.x = cvt_pk_bf16(h[0] * bf_lo(y.x), h[1] * bf_hi(y.x)); r.y = cvt_pk_bf16(h[2] * bf_lo(y.y), h[3] * bf_hi(y.y)); *(u32x2*)(YG + o) = r; }
            if (j == NCH - 1) *(f32x4*)(out + O_PH + ch4) = (f32x4){h[0], h[1], h[2], h[3]};
        }
        const float* sh = args.in[I_SH];
        for (int e = bx * 512 + tid; e < NBD * DM; e += G * 512) {
            const size_t o = (size_t)TP * DM + e; const unsigned w = AU[o]; const float h = __builtin_amdgcn_exp2f(bf_lo(w)) * sh[e] + bf_hi(w);
            out[O_SH + e] = h; YG[o] = (bf16_t)(cvt_pk_bf16(h * bf2f(YG[o]), 0.f) & 0xffffu);
        }
    }
    SEAM(7);
    if (IN(8)) {
        {
            if ((32 * (DM / 256)) % G == 0) {
            pg8::Gemm g{YG, WL, DM, DM, DM, 128, 128, (size_t)((const char*)QB - (const char*)YG), (size_t)((const char*)WA - (const char*)WL)}; pg8::Order<5> S; S.init(32, DM / 256, 0, G, bx);
            EpiProj E{GR, GA, MIX, 0}; pg8::gemm_phase(lds, g, S, E);
            } else {
            { pg8::Gemm g{YG, WL, DM, DM, DM, 128, 128, 0, 0}; pg8::Order<0> S; S.init(32, DM / 256, 0, G, bx); EpiProj E{GR, GA, MIX, 0}; pg8::gemm_phase(lds, g, S, E); }
            asm volatile("s_waitcnt vmcnt(0)" ::: "memory");
            { pg8::Gemm g{QB, WA, DM, DM, DM, 128, 128, 0, 0}; pg8::Order<0> S; S.init(32, DM / 256, 0, G, bx); EpiProj E{GR, GA, MIX, 1}; pg8::gemm_phase(lds, g, S, E); }
            } }
        {
            LAS float* p1 = (LAS float*)lds; LAS float* p2 = p1 + 8 * 64 * 32;
            for (int unit = bx; unit < 2 * (DM / 32); unit += G) {
                const int r0 = 64 * (unit & 1), n0 = 32 * (unit >> 1);
                f32x4 acc[4][2]; skinny_zero(acc);
                skinny_acc(YG + (size_t)(TP + r0) * DM, DM, WL + (size_t)n0 * DM, DM, wave * (DM / 8), DM / 256, acc, lane);
                skinny_store(p1, acc, wave, lane);
                skinny_zero(acc);
                skinny_acc(QB + (size_t)(TP + r0) * DM, DM, WA + (size_t)n0 * DM, DM, wave * (DM / 8), DM / 256, acc, lane);
                skinny_store(p2, acc, wave, lane);
                __syncthreads();
                const int rowl = tid >> 3, c4 = tid & 7; const size_t off = (size_t)(TP + r0 + rowl) * DM + n0 + 4 * c4;
                const f32x4 s1 = skinny_sum(p1, rowl, c4), s2 = skinny_sum(p2, rowl, c4);
                const u32x2 gr = *(const u32x2*)(GR + off), ga = *(const u32x2*)(GA + off);
                u32x2 w; w.x = cvt_pk_bf16(bf_lo(gr.x) * s1[0] + bf_lo(ga.x) * s2[0], bf_hi(gr.x) * s1[1] + bf_hi(ga.x) * s2[1]);
                w.y = cvt_pk_bf16(bf_lo(gr.y) * s1[2] + bf_lo(ga.y) * s2[2], bf_hi(gr.y) * s1[3] + bf_hi(ga.y) * s2[3]);
                *(u32x2*)(MIX + off) = w;
                __syncthreads();
            }
        }
    }
    SEAM(8);
    if (IN(9)) {
        pg8::Gemm g{MIX, WO, DM, DM, DM, 128, 128, 0, 0}; pg8::Order<0> S; S.init(32, DM / 256, 0, G, bx);
        EpiResid<1> E{nullptr, XB, nullptr, SS2, 1.0f};
        pg8::gemm_phase(lds, g, S, E);
        skinny_resid<1, false>(lds, MIX + (size_t)TP * DM, DM, WO, DM, nullptr, XB, SS2, nullptr, 1.0f, G, bx, tid, wave, lane);
    }
    SEAM(9);
    if (IN(10)) {
        if (cvsplit && bx >= CVG1) {
            convert_items(args, ws, lds, R_WD2, R_WIN, (bx - CVG1) * 8 + wave, (G - CVG1) * 8, wave, lane);
            {
                const int nth = (G - CVG1) * 512, th = (bx - CVG1) * 512 + tid; constexpr int RUN4 = 127 * KVW / 4;
                for (int kv = 0; kv < 2; ++kv) {
                    const float* src = args.in[kv ? I_CV : I_CK]; float* dst = out + (kv ? O_SV : O_SK);
                    for (int i0 = th; i0 < NBD * RUN4; i0 += 8 * nth) {
                        f32x4 v[8];
#pragma unroll
                        for (int e = 0; e < 8; ++e) { const int i = i0 + e * nth; if (i < NBD * RUN4) { const int b = i / RUN4, r = i - b * RUN4; v[e] = *(const f32x4*)(src + (size_t)b * 128 * KVW + KVW + 4 * (size_t)r); } }
#pragma unroll
                        for (int e = 0; e < 8; ++e) { const int i = i0 + e * nth; if (i < NBD * RUN4) { const int b = i / RUN4, r = i - b * RUN4; *(f32x4*)(dst + (size_t)b * 128 * KVW + 4 * (size_t)r) = v[e]; } }
                    }
                }
            }
        } else {
        pg8::Gemm g{XB, WGU2, DM, DM, DM, 128, 128, 0, 0}; pg8::Order<0> S; S.init(32, 2 * FF / 256, 2 * FF / 256, cvsplit ? CVG1 : G, bx);
        EpiSwiglu E{HB, SS2};
        pg8::gemm_phase(lds, g, S, E);
        }
    }
    SEAM(10);
    if (IN(11)) {
        pg8::Gemm g{HB, WD2, 64, 64, FF, (size_t)MP * 128, (size_t)DM * 128, 0, 0};   pg8::Order<0> S; S.init(32, DM / 256, 0, G, bx);
        EpiResid<2> E{nullptr, XB, out, nullptr, 0.5f};
        pg8::gemm_phase(lds, g, S, E);
        skinny_resid<2, true>(lds, HB + (size_t)TP * 64, 64, WD2, FF, nullptr, XB, nullptr, out, 0.5f, G, bx, tid, wave, lane);
    }
#undef IN
#undef SEAM
}

extern "C" void kernel_launch(void* const* d_in, const int* in_sizes, int n_in, void* d_out, int out_size, void* d_ws, size_t ws_size, hipStream_t stream) {
    static int grid = 0;
    if (grid == 0) {
        if (n_in != 29 || (size_t)out_size != O_END || ws_size < WS_END) { fprintf(stderr, "kernel_launch: unexpected shapes: n_in %d out %d (want %zu) ws %zu (need %zu)\n", n_in, out_size, (size_t)O_END, ws_size, (size_t)WS_END); grid = -1; return; }
        int dev = 0, cus = 0, per_cu = 0;
        if (hipGetDevice(&dev) != hipSuccess || hipDeviceGetAttribute(&cus, hipDeviceAttributeMultiprocessorCount, dev) != hipSuccess) { grid = -1; return; }
        if (hipFuncSetAttribute((const void*)mk_fwd, hipFuncAttributeMaxDynamicSharedMemorySize, LDS_BYTES) != hipSuccess) { fprintf(stderr, "kernel_launch: hipFuncSetAttribute failed\n"); grid = -1; return; }
        if (hipOccupancyMaxActiveBlocksPerMultiprocessor(&per_cu, (const void*)mk_fwd, 512, LDS_BYTES) != hipSuccess || per_cu < 1) fprintf(stderr, "kernel_launch: occupancy query reports %d\n", per_cu);
        (void)hipGetLastError();
        grid = cus;
    }
    if (grid < 0) return;
    (void)hipMemsetAsync((char*)d_ws + WS_CTL, 0, CTL_ZERO_BYTES, stream);
    Args a{};
    for (int i = 0; i < 29; ++i) a.in[i] = (const float*)d_in[i];
    a.out = (float*)d_out; a.ws = (unsigned char*)d_ws;
#if MK_PER_PHASE
    for (int p = 0; p < NPHASE; ++p) { a.ph_lo = p; a.ph_hi = p + 1; hipLaunchKernelGGL(mk_fwd, dim3(grid), dim3(512), LDS_BYTES, stream, a); }
#else
    a.ph_lo = 0; a.ph_hi = NPHASE;
    hipLaunchKernelGGL(mk_fwd, dim3(grid), dim3(512), LDS_BYTES, stream, a);
#endif
    const hipError_t le = hipPeekAtLastError();
    if (le != hipSuccess) fprintf(stderr, "kernel_launch: launch failed: %s\n", hipGetErrorName(le));
}
```
